# Optimizing an MI355X kernel written in HIP

```python
import math
import jax, jax.numpy as jnp
from jax import lax
import numpy as np

D_MODEL = 1024
BATCH = 8
SEQ = 2048
DEPTH = 2

HEAD_DIM = 64
SWA_HEADS = (D_MODEL // 2) // HEAD_DIM
SWA_KV_HEADS = SWA_HEADS // 4
SWA_GROUP = SWA_HEADS // SWA_KV_HEADS
WINDOW = 128
SWA_BLOCK = 128
SB_HEADS = (D_MODEL // 2) // HEAD_DIM
SB_BLOCK = 128
HG_DK = 128
HG_WIDTH = D_MODEL // 2
HG_HEADS = HG_WIDTH // HG_DK
HG_DV = HG_WIDTH // HG_HEADS
HG_CHUNK = 64
CONV_WIDTH = D_MODEL // 2
CONV_K = 3
D_FF = 2816
EPS = 1e-6

N_EVEN = (DEPTH + 1) // 2
N_ODD = DEPTH // 2
SWA_Q = SWA_HEADS * HEAD_DIM
SWA_KV = SWA_KV_HEADS * HEAD_DIM
SB_W = SB_HEADS * HEAD_DIM
ATTN_IN = SWA_Q + 2 * SWA_KV + 3 * SB_W
ATTN_OUT = SWA_Q + SB_W
REC_IN = 4 * HG_WIDTH + 3 * CONV_WIDTH
REC_OUT = HG_HEADS * HG_DV + CONV_WIDTH

kernel_name = "hybrid_swa_stickbreak_hgrn2_shortconv_macaron"

F32 = jnp.float32


def split_cols(t, sizes):
    return jnp.split(t, np.cumsum(sizes)[:-1].tolist(), axis=-1)


def rms_norm(x, g):
    x32 = x.astype(F32)
    y = x32 * lax.rsqrt(jnp.mean(x32 * x32, axis=-1, keepdims=True) + EPS)
    return (y * g.astype(F32)).astype(x.dtype)


def swiglu(x, w_in, w_out):
    gate, up = jnp.split(x @ w_in, 2, axis=-1)
    return (jax.nn.silu(gate) * up) @ w_out


def alibi_slopes(n_heads):
    return jnp.exp2(-8.0 * jnp.arange(1, n_heads + 1, dtype=F32) / n_heads)


def sliding_window_attention(q, k, v, sinks):
    b, s, _, dh = q.shape
    nb = s // SWA_BLOCK
    qb = q.reshape(b, nb, SWA_BLOCK, SWA_KV_HEADS, SWA_GROUP, dh)

    def band(t):
        tb = t.reshape(b, nb, SWA_BLOCK, SWA_KV_HEADS, dh)
        prev = jnp.concatenate([jnp.zeros_like(tb[:, :1]), tb[:, :-1]], axis=1)
        return jnp.concatenate([prev, tb], axis=2)

    kb, vb = band(k), band(v)
    scores = jnp.einsum('bnqhgd,bnkhd->bnhgqk', qb, kb).astype(F32) * (dh ** -0.5)
    qi = jnp.arange(SWA_BLOCK)[:, None]
    kj = jnp.arange(2 * SWA_BLOCK)[None, :]
    dist = qi + SWA_BLOCK - kj
    key_pos = jnp.arange(nb)[:, None, None] * SWA_BLOCK - SWA_BLOCK + kj
    valid = (dist >= 0) & (dist < WINDOW) & (key_pos >= 0)
    slopes = alibi_slopes(SWA_HEADS).reshape(SWA_KV_HEADS, SWA_GROUP)
    scores = scores - slopes[:, :, None, None] * dist.astype(F32)
    scores = jnp.where(valid[None, :, None, None], scores, -jnp.inf)
    sink = sinks.astype(F32).reshape(SWA_KV_HEADS, SWA_GROUP)[None, None, :, :, None, None]
    m = jnp.maximum(jnp.max(scores, axis=-1, keepdims=True), sink)
    p = jnp.exp(scores - m)
    probs = p / (jnp.sum(p, axis=-1, keepdims=True) + jnp.exp(sink - m))
    o = jnp.einsum('bnhgqk,bnkhd->bnqhgd', probs.astype(v.dtype), vb)
    return o.reshape(b, s, SWA_HEADS * dh)


def stick_breaking_attention(q, k, v):
    b, s, h, dh = q.shape
    outs = []
    for n in range(s // SB_BLOCK):
        start, end = n * SB_BLOCK, (n + 1) * SB_BLOCK
        z = jnp.einsum('bqhd,bkhd->bhqk', q[:, start:end], k[:, :end]).astype(F32) * (dh ** -0.5)
        t_pos = start + jnp.arange(SB_BLOCK)[:, None]
        s_pos = jnp.arange(end)[None, :]
        causal = s_pos < t_pos
        log_keep = jnp.where(causal, -jax.nn.softplus(z), 0.0)
        suffix = lax.cumsum(log_keep, axis=3, reverse=True)
        between = jnp.concatenate([suffix[..., 1:], jnp.zeros_like(suffix[..., :1])], axis=-1)
        w = jnp.where(causal, jnp.exp(jax.nn.log_sigmoid(z) + between), 0.0)
        outs.append(jnp.einsum('bhqk,bkhd->bqhd', w.astype(v.dtype), v[:, :end]))
    return jnp.concatenate(outs, axis=1).reshape(b, s, h * dh)


def hgrn_lower_bounds(logits):
    c = jnp.cumsum(jax.nn.softmax(logits.astype(F32), axis=0), axis=0)
    return c - c[0:1]


def hgrn2(q, f_logit, i, lb):
    b, s, h, dk = q.shape
    nc = s // HG_CHUNK
    z = f_logit.astype(F32)
    lb = lb.astype(F32)
    log_f = jnp.log(lb + (1.0 - lb) * jax.nn.sigmoid(z))
    key = (1.0 - lb) * jax.nn.sigmoid(-z)
    qf = jax.nn.silu(q.astype(F32))
    vf = i.astype(F32)

    def chunks(t):
        return t.reshape(b, nc, HG_CHUNK, h, t.shape[-1]).transpose(1, 0, 3, 2, 4)

    qc, kc, vc = chunks(qf), chunks(key), chunks(vf)
    gc = lax.cumsum(chunks(log_f), axis=3)
    causal = jnp.tril(jnp.ones((HG_CHUNK, HG_CHUNK), dtype=bool))[:, :, None]

    def step(state, inp):
        qt, kt, vt, gt = inp
        o_inter = jnp.einsum('bhtd,bhde->bhte', qt * jnp.exp(gt), state)
        diff = gt[:, :, :, None, :] - gt[:, :, None, :, :]
        decay = jnp.exp(jnp.where(causal, diff, -jnp.inf))
        scores = jnp.einsum('bhtd,bhsd,bhtsd->bhts', qt, kt, decay)
        o_intra = jnp.einsum('bhts,bhse->bhte', scores, vt)
        g_last = gt[:, :, -1:, :]
        state = (jnp.exp(g_last)[:, :, 0, :, None] * state
                 + jnp.einsum('bhsd,bhse->bhde', kt * jnp.exp(g_last - gt), vt))
        return state, o_inter + o_intra

    init = jnp.zeros((b, h, dk, vf.shape[-1]), F32)
    _, o = lax.scan(step, init, (qc, kc, vc, gc))
    return o.transpose(1, 0, 3, 2, 4).reshape(b, s, h, vf.shape[-1])


def short_conv(u, w):
    return lax.conv_general_dilated(u, w[:, None, :].astype(u.dtype), window_strides=(1,),
                                    padding=[(CONV_K - 1, 0)],
                                    dimension_numbers=('NWC', 'WIO', 'NWC'),
                                    feature_group_count=u.shape[-1])


def attention_mixer(h, w_in, sinks, w_out):
    b, s, _ = h.shape
    q_a, k_a, v_a, q_b, k_b, v_b = split_cols(h @ w_in, (SWA_Q, SWA_KV, SWA_KV, SB_W, SB_W, SB_W))
    o_a = sliding_window_attention(q_a.reshape(b, s, SWA_HEADS, HEAD_DIM),
                                   k_a.reshape(b, s, SWA_KV_HEADS, HEAD_DIM),
                                   v_a.reshape(b, s, SWA_KV_HEADS, HEAD_DIM), sinks)
    o_b = stick_breaking_attention(q_b.reshape(b, s, SB_HEADS, HEAD_DIM),
                                   k_b.reshape(b, s, SB_HEADS, HEAD_DIM),
                                   v_b.reshape(b, s, SB_HEADS, HEAD_DIM))
    return jnp.concatenate([o_a.astype(h.dtype), o_b.astype(h.dtype)], axis=-1) @ w_out


def recurrent_conv_mixer(h, w_in, lb, out_norm_g, conv_w, w_out):
    b, s, _ = h.shape
    q, f, i, g, gate_b, gate_c, u = split_cols(
        h @ w_in, (HG_WIDTH, HG_WIDTH, HG_WIDTH, HG_WIDTH, CONV_WIDTH, CONV_WIDTH, CONV_WIDTH))
    hs = (b, s, HG_HEADS, HG_DK)
    o_c = hgrn2(q.reshape(hs), f.reshape(hs), i.reshape(b, s, HG_HEADS, HG_DV),
                lb.reshape(HG_HEADS, HG_DK))
    o_c = rms_norm(o_c, out_norm_g).reshape(b, s, HG_HEADS * HG_DV) * jax.nn.silu(g.astype(F32))
    o_d = gate_b * short_conv(gate_c * u, conv_w)
    return jnp.concatenate([o_c.astype(h.dtype), o_d.astype(h.dtype)], axis=-1) @ w_out


def setup_inputs(seed: int = 0) -> dict:
    key = jax.random.key(seed)
    ks = jax.random.split(key, 13)

    def w(k, shape, fan_in):
        return jax.random.normal(k, shape, F32) * (fan_in ** -0.5)

    def gain(k, shape):
        return 1.0 + 0.02 * jax.random.normal(k, shape, F32)

    return {
        "x": jax.random.normal(ks[0], (BATCH, SEQ, D_MODEL), F32),
        "norm_g": gain(ks[1], (DEPTH, 3, D_MODEL)),
        "ffn_w_in": w(ks[2], (DEPTH, 2, D_MODEL, 2 * D_FF), D_MODEL),
        "ffn_w_out": w(ks[3], (DEPTH, 2, D_FF, D_MODEL), D_FF),
        "attn_w_in": w(ks[4], (N_EVEN, D_MODEL, ATTN_IN), D_MODEL),
        "attn_sinks": 0.5 * jax.random.normal(ks[5], (N_EVEN, SWA_HEADS), F32),
        "attn_w_out": w(ks[6], (N_EVEN, ATTN_OUT, D_MODEL), ATTN_OUT),
        "rec_w_in": w(ks[7], (N_ODD, D_MODEL, REC_IN), D_MODEL),
        "hgrn_lb_logits": jax.random.normal(ks[8], (DEPTH, HG_WIDTH), F32),
        "hgrn_norm_g": gain(ks[9], (N_ODD, HG_DV)),
        "conv_w": w(ks[10], (N_ODD, CONV_K, CONV_WIDTH), CONV_K),
        "rec_w_out": w(ks[11], (N_ODD, REC_OUT, D_MODEL), REC_OUT),
        "final_g": gain(ks[12], (D_MODEL,)),
    }


def reference(x, norm_g, ffn_w_in, ffn_w_out, attn_w_in, attn_sinks, attn_w_out,
              rec_w_in, hgrn_lb_logits, hgrn_norm_g, conv_w, rec_w_out, final_g):
    lower_bounds = hgrn_lower_bounds(hgrn_lb_logits)
    h = x
    for layer in range(DEPTH):
        h = h + 0.5 * swiglu(rms_norm(h, norm_g[layer, 0]), ffn_w_in[layer, 0], ffn_w_out[layer, 0])
        hn = rms_norm(h, norm_g[layer, 1])
        if layer % 2 == 0:
            e = layer // 2
            mix = attention_mixer(hn, attn_w_in[e], attn_sinks[e], attn_w_out[e])
        else:
            o = layer // 2
            mix = recurrent_conv_mixer(hn, rec_w_in[o], lower_bounds[layer], hgrn_norm_g[o],
                                       conv_w[o], rec_w_out[o])
        h = h + mix
        h = h + 0.5 * swiglu(rms_norm(h, norm_g[layer, 2]), ffn_w_in[layer, 1], ffn_w_out[layer, 1])
    return rms_norm(h, final_g)
```

```cpp
#include <hip/hip_runtime.h>
#include <cstdio>
#include <cstdint>
namespace pg8 {
#define PG8_LAS __attribute__((address_space(3)))
typedef unsigned short bf16_t;
typedef short bf16x8 __attribute__((ext_vector_type(8)));
typedef float f32x4 __attribute__((ext_vector_type(4)));
typedef unsigned u32x4 __attribute__((ext_vector_type(4)));
constexpr int BM = 256, BK = 64, HALF = 128, HTB = HALF * BK * 2  , STAGE_BYTES = 8 * HTB, NXCD = 8, WGM = 8;

__host__ __device__ __forceinline__ int lds_byte(int r, int c) { const int st = (r >> 4) * 2 + (c >> 5), rr = r & 15, cc = c & 31, ob = rr * 64 + cc * 2; return st * 1024 + (ob ^ (((ob >> 9) & 1) << 5)); }
__host__ __device__ __forceinline__ void stage_rc(int b, int& R, int& C) { const int st = b / 1024, sb = b % 1024, swz = sb ^ (((sb >> 9) & 1) << 5); R = (st >> 1) * 16 + swz / 64; C = (st & 1) * 32 + (swz % 64) / 2; }
__host__ __device__ __forceinline__ int perm32(int rho) { const int n = rho >> 4, i = rho & 15; return 8 * (i >> 2) + 4 * n + (i & 3); }

struct Unit { int pm, pn; };
struct Gemm { const bf16_t* A; const bf16_t* Bt; int M, N, K; };

struct StaticOrder {
    int nM, nN, nwg, G, c;
    __host__ __device__ void init(int M, int N, int G_, int c_) { nM = M / BM; nN = N / BM; nwg = nM * nN; G = G_; c = c_; }
    __host__ __device__ bool next(int i, Unit& u) const {
        const long L = (long)i * G + c; if (L >= nwg) return false;
        int wgid = (int)L; { const int q = nwg / NXCD, r = nwg % NXCD, xcd = wgid % NXCD, off = wgid / NXCD; wgid = (xcd < r ? xcd * (q + 1) : r * (q + 1) + (xcd - r) * q) + off; }
        const int nig = WGM * nN, gid = wgid / nig, fm = gid * WGM, gsz = (nM - fm) < WGM ? (nM - fm) : WGM;
        u.pm = fm + ((wgid % nig) % gsz); u.pn = (wgid % nig) / gsz; return true;
    }
    __device__ __forceinline__ void a_ready(const Unit&) const {}
    __device__ __forceinline__ void done(const Unit&) const {}
};
typedef float f32x2_t __attribute__((ext_vector_type(2))); typedef __bf16 bf16x2_t __attribute__((ext_vector_type(2)));
__device__ __forceinline__ unsigned cvt_pk_bf16(float lo, float hi) { f32x2_t v = {lo, hi}; bf16x2_t b = __builtin_convertvector(v, bf16x2_t); return __builtin_bit_cast(unsigned, b); }
__device__ __forceinline__ u32x4 pack8(const f32x4 a, const f32x4 b) { u32x4 w; w.x = cvt_pk_bf16(a[0], a[1]); w.y = cvt_pk_bf16(a[2], a[3]); w.z = cvt_pk_bf16(b[0], b[1]); w.w = cvt_pk_bf16(b[2], b[3]); return w; }
constexpr float RMS_EPS = 1e-6f;
__device__ __forceinline__ float row_rstd(const float* part, int row, int fq) {
    const f32x4 p = *(const f32x4*)(part + (size_t)row * 16 + fq * 4);
    float s = (p[0] + p[1]) + (p[2] + p[3]);
    s += __shfl_xor(s, 16); s += __shfl_xor(s, 32);
    return 1.0f / sqrtf(s * (1.0f / 1024.0f) + RMS_EPS);
}
__device__ __forceinline__ float silu_f(float x) { return x * __builtin_amdgcn_rcpf(1.0f + __expf(-x)); }
struct EpiRowScale {
    static constexpr bool PERM = true, AFTER_DRAIN = false;
    bf16_t* O; int ldc; const float* part;
    __device__ __forceinline__ void operator()(const f32x4 (&acc)[2][2][4][2], const Unit& u, int wr, int wc, int fr, int fq) const {
        const int row0 = u.pm * BM + wr * 64 + fr, col0 = u.pn * BM + wc * 32 + 8 * fq;
#pragma unroll
        for (int ai = 0; ai < 2; ++ai)
#pragma unroll
            for (int m = 0; m < 4; ++m) { const int row = row0 + ai * HALF + m * 16; const float r = row_rstd(part, row, fq);
                bf16_t* rowp = O + (size_t)row * ldc + col0;
#pragma unroll
                for (int bj = 0; bj < 2; ++bj) *(u32x4*)(rowp + bj * HALF) = pack8(acc[ai][bj][m][0] * r, acc[ai][bj][m][1] * r);
                asm volatile("" ::: "memory"); }
    }
};
struct EpiSwiglu {
    static constexpr bool PERM = true, AFTER_DRAIN = false;
    bf16_t* O; int ldc; const float* part;
    __device__ __forceinline__ void operator()(const f32x4 (&acc)[2][2][4][2], const Unit& u, int wr, int wc, int fr, int fq) const {
        const int row0 = u.pm * BM + wr * 64 + fr, col0 = u.pn * HALF + wc * 32 + 8 * fq;
#pragma unroll
        for (int ai = 0; ai < 2; ++ai)
#pragma unroll
            for (int m = 0; m < 4; ++m) { const int row = row0 + ai * HALF + m * 16; const float r = row_rstd(part, row, fq);
                f32x4 o[2];
#pragma unroll
                for (int n = 0; n < 2; ++n) { const f32x4 g = acc[ai][0][m][n] * r, up = acc[ai][1][m][n] * r;
#pragma unroll
                    for (int i = 0; i < 4; ++i) o[n][i] = silu_f(g[i]) * up[i]; }
                *(u32x4*)(O + (size_t)row * ldc + col0) = pack8(o[0], o[1]);
                asm volatile("" ::: "memory"); }
    }
};
struct EpiResid {
    static constexpr bool PERM = true, AFTER_DRAIN = false;
    const float* base; float* out; bf16_t* ob; float* part; float scale;
    __device__ __forceinline__ void operator()(const f32x4 (&acc)[2][2][4][2], const Unit& u, int wr, int wc, int fr, int fq) const {
        const int row0 = u.pm * BM + wr * 64 + fr, col0 = u.pn * BM + wc * 32 + 8 * fq;
#pragma unroll
        for (int ai = 0; ai < 2; ++ai)
#pragma unroll
            for (int m = 0; m < 4; ++m) { const int row = row0 + ai * HALF + m * 16; const size_t off = (size_t)row * 1024 + col0; float ss = 0.f;
#pragma unroll
                for (int bj = 0; bj < 2; ++bj) { const f32x4 b0 = *(const f32x4*)(base + off + bj * HALF), b1 = *(const f32x4*)(base + off + bj * HALF + 4);
                    const f32x4 h0 = b0 + acc[ai][bj][m][0] * scale, h1 = b1 + acc[ai][bj][m][1] * scale;
                    *(f32x4*)(out + off + bj * HALF) = h0; *(f32x4*)(out + off + bj * HALF + 4) = h1;
                    *(u32x4*)(ob + off + bj * HALF) = pack8(h0, h1);
                    ss += (h0[0] * h0[0] + h0[1] * h0[1]) + (h0[2] * h0[2] + h0[3] * h0[3]) + (h1[0] * h1[0] + h1[1] * h1[1]) + (h1[2] * h1[2] + h1[3] * h1[3]); }
                ss += __shfl_xor(ss, 16); ss += __shfl_xor(ss, 32);
                if (fq == 0) part[(size_t)row * 16 + u.pn * 4 + wc] = ss;
                asm volatile("" ::: "memory"); }
    }
};

template <class Epi, class Sched, bool ALIGN_EPI = false, bool SP2 = false>
__device__ __forceinline__ void gemm_phase(PG8_LAS unsigned char* lds, const Gemm g, const Sched& S, const Epi& E) {
    const int tid = threadIdx.x, wid = __builtin_amdgcn_readfirstlane(tid >> 6), lane = tid & 63, wr = wid >> 2, wc = wid & 3, fr = lane & 15, fq = lane >> 4;
    const int K = g.K, nt = K / BK;
    unsigned voffA[2], voffB[2];
#pragma unroll
    for (int i = 0; i < 2; ++i) { int R, C; stage_rc(tid * 16 + i * 8192, R, C); const int Rb = Epi::PERM ? ((R & ~31) + perm32(R & 31)) : R;
        voffA[i] = (unsigned)(R * K + C) * 2u; voffB[i] = (unsigned)(Rb * K + C) * 2u; }
    const size_t kstep = (size_t)(BK * 2);
    const size_t hstep = (size_t)HALF * K * 2;
    const size_t tstep = 2 * hstep;
    const unsigned ldsw = (unsigned)wid * 1024u;
    const int aoff = lds_byte(wr * 64 + fr, fq * 8), boff = lds_byte(wc * 32 + fr, fq * 8);
#define PG8_SA(b, h) (((b) * 2 + (h)) * HTB)
#define PG8_SB(b, h) ((4 + (b) * 2 + (h)) * HTB)
#define PG8_STAGE(bufoff, gbase, voff) do { _Pragma("unroll") for (int _i = 0; _i < 2; ++_i) \
        __builtin_amdgcn_global_load_lds((const unsigned*)((const char*)(gbase) + (voff)[_i]), (PG8_LAS unsigned*)(lds + (bufoff) + ldsw + _i * 8192), 16, 0, 0); } while (0)
#define PG8_LDA(dst, b, h) do { _Pragma("unroll") for (int m = 0; m < 4; ++m) _Pragma("unroll") for (int k = 0; k < 2; ++k) dst[m][k] = *(const PG8_LAS bf16x8*)(lds + PG8_SA(b, h) + aoff + m * 2048 + k * 1024); } while (0)
#define PG8_LDB(dst, b, h) do { _Pragma("unroll") for (int n = 0; n < 2; ++n) _Pragma("unroll") for (int k = 0; k < 2; ++k) dst[n][k] = *(const PG8_LAS bf16x8*)(lds + PG8_SB(b, h) + boff + n * 2048 + k * 1024); } while (0)
#define PG8_MMA(ai, bj, At, Bt) do { __builtin_amdgcn_s_setprio(1); _Pragma("unroll") for (int m = 0; m < 4; ++m) _Pragma("unroll") for (int n = 0; n < 2; ++n) _Pragma("unroll") for (int k = 0; k < 2; ++k) \
        acc[ai][bj][m][n] = __builtin_amdgcn_mfma_f32_16x16x32_bf16(Bt[n][k], At[m][k], acc[ai][bj][m][n], 0, 0, 0); __builtin_amdgcn_s_setprio(0); } while (0)
#define PG8_WAIT_V(n) asm volatile("s_waitcnt vmcnt(" #n ")" ::: "memory")
#define PG8_WAIT_L(n) asm volatile("s_waitcnt lgkmcnt(" #n ")" ::: "memory")
#define PG8_BAR __builtin_amdgcn_s_barrier()
#define PG8_SCHED __builtin_amdgcn_sched_barrier(0)
    Unit cur, nxt; int ui = 0;
    if (!S.next(0, cur)) return;
    f32x4 acc[2][2][4][2];
#pragma unroll
    for (int a = 0; a < 2; ++a)
#pragma unroll
        for (int b = 0; b < 2; ++b)
#pragma unroll
            for (int m = 0; m < 4; ++m)
#pragma unroll
                for (int n = 0; n < 2; ++n) acc[a][b][m][n] = (f32x4){0.f, 0.f, 0.f, 0.f};
    bf16x8 At[4][2], B0[2][2], B1[2][2];
    const char* cA = (const char*)g.A + (size_t)cur.pm * tstep; const char* cB = (const char*)g.Bt + (size_t)cur.pn * tstep;
    S.a_ready(cur);
    if constexpr (SP2) {
        PG8_STAGE(PG8_SB(0, 0), cB, voffB); PG8_STAGE(PG8_SB(0, 1), cB + hstep, voffB); PG8_STAGE(PG8_SA(0, 0), cA, voffA); PG8_STAGE(PG8_SA(0, 1), cA + hstep, voffA);
        if (wr == 1) PG8_BAR;
        PG8_WAIT_V(2); PG8_BAR;
        PG8_STAGE(PG8_SB(1, 0), cB + kstep, voffB); PG8_STAGE(PG8_SA(1, 0), cA + kstep, voffA); PG8_STAGE(PG8_SB(1, 1), cB + hstep + kstep, voffB);
        PG8_WAIT_V(6); PG8_BAR;
    } else {
        PG8_STAGE(PG8_SB(0, 0), cB, voffB); PG8_STAGE(PG8_SA(0, 0), cA, voffA); PG8_STAGE(PG8_SB(0, 1), cB + hstep, voffB); PG8_STAGE(PG8_SA(0, 1), cA + hstep, voffA);
        if (wr == 1) PG8_BAR;
        PG8_WAIT_V(4); PG8_BAR;
        PG8_STAGE(PG8_SB(1, 0), cB + kstep, voffB); PG8_STAGE(PG8_SA(1, 0), cA + kstep, voffA); PG8_STAGE(PG8_SB(1, 1), cB + hstep + kstep, voffB);
        PG8_WAIT_V(6); PG8_BAR;
    }
    for (;;) {
        const bool has_next = S.next(ui + 1, nxt);
        const char* nA = has_next ? (const char*)g.A + (size_t)nxt.pm * tstep : cA; const char* nB = has_next ? (const char*)g.Bt + (size_t)nxt.pn * tstep : cB;
        for (int t = 0; t < nt; t += 2) {
            const bool last = (t == nt - 2);
            const char* a1 = cA + (size_t)(t + 1) * kstep;
            const char* a2 = last ? nA : cA + (size_t)(t + 2) * kstep; const char* b2 = last ? nB : cB + (size_t)(t + 2) * kstep;
            const char* a3 = a2 + kstep; const char* b3 = b2 + kstep;
            if (last && has_next) S.a_ready(nxt);
            if constexpr (SP2) {
            PG8_LDB(B0, 0, 0); PG8_LDB(B1, 0, 1); PG8_SCHED; PG8_LDA(At, 0, 0); PG8_STAGE(PG8_SA(1, 1), a1 + hstep, voffA);
            PG8_WAIT_V(8); PG8_WAIT_L(0); PG8_BAR; PG8_MMA(0, 0, At, B0); PG8_MMA(0, 1, At, B1); PG8_BAR; PG8_SCHED;
            PG8_LDA(At, 0, 1); PG8_STAGE(PG8_SB(0, 0), b2, voffB); PG8_STAGE(PG8_SB(0, 1), b2 + hstep, voffB); PG8_STAGE(PG8_SA(0, 0), a2, voffA);
            PG8_WAIT_V(8); PG8_WAIT_L(0); PG8_BAR; PG8_MMA(1, 0, At, B0); PG8_MMA(1, 1, At, B1); PG8_BAR; PG8_SCHED;
            PG8_LDB(B0, 1, 0); PG8_LDB(B1, 1, 1); PG8_SCHED; PG8_LDA(At, 1, 0); PG8_STAGE(PG8_SA(0, 1), a2 + hstep, voffA);
            PG8_WAIT_V(8); PG8_WAIT_L(0); PG8_BAR; PG8_MMA(0, 0, At, B0); PG8_MMA(0, 1, At, B1); PG8_BAR; PG8_SCHED;
            PG8_LDA(At, 1, 1); PG8_STAGE(PG8_SB(1, 0), b3, voffB); PG8_STAGE(PG8_SB(1, 1), b3 + hstep, voffB); PG8_STAGE(PG8_SA(1, 0), a3, voffA);
            PG8_WAIT_V(8); PG8_WAIT_L(0); PG8_BAR; PG8_MMA(1, 0, At, B0); PG8_MMA(1, 1, At, B1); PG8_BAR; PG8_SCHED;
            } else {
            PG8_LDB(B0, 0, 0); PG8_SCHED; PG8_LDA(At, 0, 0); PG8_STAGE(PG8_SA(1, 1), a1 + hstep, voffA);
            PG8_WAIT_L(8); PG8_BAR; PG8_WAIT_L(0); PG8_MMA(0, 0, At, B0); PG8_BAR; PG8_SCHED;
            PG8_LDB(B1, 0, 1); PG8_STAGE(PG8_SB(0, 0), b2, voffB);
            PG8_BAR; PG8_WAIT_L(0); PG8_MMA(0, 1, At, B1); PG8_BAR;
            PG8_LDA(At, 0, 1); PG8_STAGE(PG8_SA(0, 0), a2, voffA);
            PG8_BAR; PG8_WAIT_L(0); PG8_MMA(1, 0, At, B0); PG8_BAR; PG8_SCHED;
            PG8_STAGE(PG8_SB(0, 1), b2 + hstep, voffB);
            PG8_WAIT_V(6); PG8_BAR; PG8_MMA(1, 1, At, B1); PG8_BAR;
            PG8_LDB(B0, 1, 0); PG8_SCHED; PG8_LDA(At, 1, 0); PG8_STAGE(PG8_SA(0, 1), a2 + hstep, voffA);
            PG8_WAIT_L(8); PG8_BAR; PG8_WAIT_L(0); PG8_MMA(0, 0, At, B0); PG8_BAR; PG8_SCHED;
            PG8_LDB(B1, 1, 1); PG8_STAGE(PG8_SB(1, 0), b3, voffB);
            PG8_BAR; PG8_WAIT_L(0); PG8_MMA(0, 1, At, B1); PG8_BAR;
            PG8_LDA(At, 1, 1); PG8_STAGE(PG8_SA(1, 0), a3, voffA);
            PG8_BAR; PG8_WAIT_L(0); PG8_MMA(1, 0, At, B0); PG8_BAR; PG8_SCHED;
            PG8_STAGE(PG8_SB(1, 1), b3 + hstep, voffB);
            PG8_WAIT_V(6); PG8_BAR; PG8_MMA(1, 1, At, B1); PG8_BAR;
            }
        }
        if constexpr (ALIGN_EPI) { if (wr == 0) PG8_BAR; }
        if constexpr (!Epi::AFTER_DRAIN) { E(acc, cur, wr, wc, fr, fq); S.done(cur); }
        if (!has_next) break;
#pragma unroll
        for (int a = 0; a < 2; ++a)
#pragma unroll
            for (int b = 0; b < 2; ++b)
#pragma unroll
                for (int m = 0; m < 4; ++m)
#pragma unroll
                    for (int n = 0; n < 2; ++n) acc[a][b][m][n] = (f32x4){0.f, 0.f, 0.f, 0.f};
        cur = nxt; cA = nA; cB = nB; ++ui;
        if constexpr (ALIGN_EPI) { if (wr == 1) PG8_BAR; }
    }
    PG8_WAIT_V(0);
    if constexpr (!ALIGN_EPI) { if (wr == 0) PG8_BAR; }
    PG8_BAR;
    if constexpr (Epi::AFTER_DRAIN) { E.fused(acc, cur, wr, wc, fr, fq, lds, wid, lane); S.done(cur); }
#undef PG8_SA
#undef PG8_SB
#undef PG8_STAGE
#undef PG8_LDA
#undef PG8_LDB
#undef PG8_MMA
#undef PG8_WAIT_V
#undef PG8_WAIT_L
#undef PG8_BAR
#undef PG8_SCHED
}
}

constexpr int NWAVES = 8;
constexpr int BATCH = 8, SEQ = 2048, DM = 1024, FF = 2816, M = BATCH * SEQ;
constexpr int AIN = 2304, RIN = 3584;
constexpr float SB_EXIT = -105.0f;

constexpr size_t MiB = 1u << 20;
constexpr size_t WS_CTL = 0, CTL_ZERO_BYTES = 1 * MiB;
constexpr size_t WS_WFIN = 2 * MiB;
constexpr size_t WS_WFOUT = 46 * MiB;
constexpr size_t WS_WAIN = 68 * MiB, WS_WAOUT = 73 * MiB, WS_WRIN = 75 * MiB, WS_WROUT = 82 * MiB;
constexpr size_t WS_PART = 84 * MiB;
constexpr size_t WS_DEC = 85 * MiB;
constexpr size_t WS_HB = 86 * MiB;
constexpr size_t WS_OB = 118 * MiB;
constexpr size_t WS_ACT = 150 * MiB;
constexpr size_t WS_ST = 262 * MiB;
constexpr size_t WS_END = 326 * MiB;
constexpr int CW_BAR = 4096;

constexpr int RING_OFF = 0, RING_BYTES = 131072;
constexpr int LDSCTL_OFF = RING_BYTES, MISC_OFF = LDSCTL_OFF + 320;
constexpr int LDS_BYTES = 147456;

#define GAS __attribute__((address_space(1)))
#define LAS __attribute__((address_space(3)))
typedef unsigned short bf16;
typedef unsigned v4u __attribute__((ext_vector_type(4)));
typedef float f32x4 __attribute__((ext_vector_type(4)));
typedef short bf16x8 __attribute__((ext_vector_type(8)));
typedef GAS unsigned gu32;
typedef GAS unsigned long long gu64;
#define RLX_AGENT __ATOMIC_RELAXED, __HIP_MEMORY_SCOPE_AGENT
#define LDS_WAIT() asm volatile("s_waitcnt lgkmcnt(0)" ::: "memory")
#define VM_WAIT() asm volatile("s_waitcnt vmcnt(0)" ::: "memory")
__device__ __forceinline__ unsigned long long rt() { return __builtin_amdgcn_s_memrealtime(); }
__device__ __forceinline__ unsigned f2bf(float f) { unsigned u = __builtin_bit_cast(unsigned, f); return (u + 0x7fffu + ((u >> 16) & 1u)) >> 16; }
__device__ __forceinline__ unsigned pk2(float lo, float hi) { return f2bf(lo) | (f2bf(hi) << 16); }

#define XB_TMO      128
#define XB_XCNT(j)  (256  + 64 * (j))
#define XB_XSUB(j)  (1280 + 64 * (j))
#define XB_XGEN(j)  (2304 + 64 * (j))
#define XB_TOP      3328
#define XB_TOPGEN   3392
#define XCD_BAR_WORDS 3456
#define XB_SPIN_CAP (1u << 18)

__device__ __forceinline__ unsigned xb_ld(unsigned* p)              { return __hip_atomic_load(p, __ATOMIC_RELAXED, __HIP_MEMORY_SCOPE_AGENT); }
__device__ __forceinline__ unsigned xb_add(unsigned* p, unsigned v) { return __hip_atomic_fetch_add(p, v, __ATOMIC_RELAXED, __HIP_MEMORY_SCOPE_AGENT); }
__device__ __forceinline__ unsigned xb_xcc_id() { return (unsigned)__builtin_amdgcn_s_getreg((3 << 11) | 20) & 0xFu; }
#define XB_SPIN(cond, bar) do { unsigned _sp = 0; while (cond) { __builtin_amdgcn_s_sleep(1); \
    if ((++_sp & 255u) == 0u) { if (xb_ld(&(bar)[XB_TMO])) break; if (_sp > XB_SPIN_CAP) { atomicAdd(&(bar)[XB_TMO], 1u); break; } } } } while (0)

struct XcdBarrier {
    unsigned* bar; unsigned x;
    volatile LAS unsigned* st;
};

__device__ __forceinline__ XcdBarrier xcd_barrier_post(unsigned* bar, volatile LAS unsigned* st) {
    XcdBarrier b; b.bar = bar; b.x = xb_xcc_id(); b.st = st;
    if (threadIdx.x == 0) (void)xb_add(&bar[XB_XCNT(b.x)], 1u);
    return b;
}
__device__ __forceinline__ void xcd_barrier_complete(unsigned* bar, unsigned x, unsigned& nloc, unsigned& nx) {
    const unsigned G = gridDim.x * gridDim.y * gridDim.z;
    unsigned sum, cnt, mine, sp = 0u;
    for (;;) {
        sum = 0u; cnt = 0u; mine = 0u;
#pragma unroll
        for (unsigned j = 0; j < 16; ++j) { const unsigned c = xb_ld(&bar[XB_XCNT(j)]); sum += c; cnt += (c > 0u) ? 1u : 0u; mine = (j == x) ? c : mine; }
        if (sum == G) break;
        __builtin_amdgcn_s_sleep(1);
        if ((++sp & 255u) == 0u) { if (xb_ld(&bar[XB_TMO])) break; if (sp > XB_SPIN_CAP) { atomicAdd(&bar[XB_TMO], 1u); break; } }
    }
    nloc = mine > 0u ? mine : 1u; nx = cnt > 0u ? cnt : 1u;
}

__device__ __forceinline__ void xcd_barrier(const XcdBarrier& b) {
    asm volatile("s_waitcnt vmcnt(0)" ::: "memory");
    __syncthreads();
    if (threadIdx.x == 0) {
        unsigned* bar = b.bar;
        __builtin_amdgcn_s_waitcnt(0);
        unsigned nloc = b.st[0], nx = b.st[1];
        if (nloc == 0u) { xcd_barrier_complete(bar, b.x, nloc, nx); b.st[0] = nloc; b.st[1] = nx; }
        const unsigned old = xb_add(&bar[XB_XSUB(b.x)], 1u);
        const unsigned gen = old / nloc;
        if (old + 1u == (gen + 1u) * nloc) {
            __builtin_amdgcn_fence(__ATOMIC_RELEASE, "agent");
            asm volatile("s_waitcnt vmcnt(0)" ::: "memory");
            const unsigned og = xb_add(&bar[XB_TOP], 1u);
            const unsigned tg = og / nx;
            if (og + 1u == (tg + 1u) * nx) xb_add(&bar[XB_TOPGEN], 1u);
            else XB_SPIN(xb_ld(&bar[XB_TOPGEN]) == tg, bar);
            __builtin_amdgcn_fence(__ATOMIC_ACQUIRE, "agent");
            xb_add(&bar[XB_XGEN(b.x)], 1u);
            asm volatile("s_waitcnt vmcnt(0)" ::: "memory");
        } else {
            XB_SPIN(xb_ld(&bar[XB_XGEN(b.x)]) == gen, bar);
            __builtin_amdgcn_fence(__ATOMIC_ACQUIRE, "agent");
            asm volatile("s_waitcnt vmcnt(0)" ::: "memory");
        }
    }
    __syncthreads();
}


typedef float f32x16 __attribute__((ext_vector_type(16)));
typedef unsigned u32x2v __attribute__((ext_vector_type(2)));
__device__ __forceinline__ float bf2f(unsigned short v) { return __uint_as_float((unsigned)v << 16); }
__device__ __forceinline__ int crow(int r, int hi) { return (r & 3) + 8 * (r >> 2) + 4 * hi; }
__device__ __forceinline__ int swap23(int k) { return (k & ~12) | ((k & 4) << 1) | ((k & 8) >> 1); }
#define MFMA32(a, b, c) __builtin_amdgcn_mfma_f32_32x32x16_bf16((a), (b), (c), 0, 0, 0)
__device__ __forceinline__ bf16x8 packf8(float a0, float a1, float a2, float a3, float a4, float a5, float a6, float a7) {
    v4u w; w.x = pg8::cvt_pk_bf16(a0, a1); w.y = pg8::cvt_pk_bf16(a2, a3); w.z = pg8::cvt_pk_bf16(a4, a5); w.w = pg8::cvt_pk_bf16(a6, a7); return __builtin_bit_cast(bf16x8, w); }
__device__ __forceinline__ float wave_sum(float v) {
#pragma unroll
    for (int o = 1; o < 64; o <<= 1) v += __shfl_xor(v, o);
    return v;
}

__device__ __forceinline__ void p0_item(const float* W, int K, int N, bf16* WT, const float* gain, bool swg, LAS float* scr, int item, int lane) {
    const int nblk = N / 32, kb = item / nblk, nb = item % nblk, k0 = 64 * kb, n0 = 32 * nb;
    int sn0 = n0; if (swg) { const int pn = n0 >> 8, bj = (n0 >> 7) & 1, x0 = n0 & 127; sn0 = bj * FF + pn * 128 + x0; }
#pragma unroll 8
    for (int i = 0; i < 32; ++i) { const int kk = 2 * i + (lane >> 5); const float gv = gain ? gain[k0 + kk] : 1.0f; scr[kk * 33 + (lane & 31)] = W[(size_t)(k0 + kk) * N + sn0 + (lane & 31)] * gv; }
    LDS_WAIT(); asm volatile("" ::: "memory");
    const int c = lane & 7;
#pragma unroll
    for (int j = 0; j < 4; ++j) { const int n = (lane >> 3) + 8 * j; const LAS float* s = scr + (8 * c) * 33 + n;
        v4u o; o.x = pk2(s[0 * 33], s[1 * 33]); o.y = pk2(s[2 * 33], s[3 * 33]); o.z = pk2(s[4 * 33], s[5 * 33]); o.w = pk2(s[6 * 33], s[7 * 33]);
        *(GAS v4u*)(WT + (size_t)(n0 + n) * K + k0 + 8 * c) = o; }
    LDS_WAIT(); asm volatile("" ::: "memory");
}

struct Ptrs {
    const float *x, *norm_g, *ffn_w_in, *ffn_w_out, *attn_w_in, *attn_sinks, *attn_w_out, *rec_w_in, *lb_logits, *hgrn_norm_g, *conv_w, *rec_w_out, *final_g;
    float* out; unsigned char* ws;
};

__device__ __forceinline__ void p0_prologue(const Ptrs& P, LAS unsigned char* lds, int wave, int lane) {
    LAS float* scr = (LAS float*)(lds + RING_OFF + wave * 16384);
    const int gw = blockIdx.x * NWAVES + wave, NGW = gridDim.x * NWAVES;
    constexpr int I_FIN = (DM / 64) * (2 * FF / 32), I_FOUT = (FF / 64) * (DM / 32), I_AIN = (DM / 64) * (AIN / 32), I_O = (DM / 64) * (DM / 32), I_RIN = (DM / 64) * (RIN / 32);
    constexpr int NITEMS = 4 * I_FIN + 4 * I_FOUT + I_AIN + I_O + I_RIN + I_O;
    unsigned char* ws = P.ws;
    for (int it = gw; it < NITEMS; it += NGW) {
        int r = it;
        if (r < 4 * I_FIN) { const int w = r / I_FIN, l = w >> 1, j = w & 1; p0_item(P.ffn_w_in + (size_t)w * DM * 2 * FF, DM, 2 * FF, (bf16*)(ws + WS_WFIN) + (size_t)w * 2 * FF * DM, P.norm_g + (l * 3 + (j ? 2 : 0)) * DM, true, scr, r % I_FIN, lane); continue; } r -= 4 * I_FIN;
        if (r < 4 * I_FOUT) { const int w = r / I_FOUT; p0_item(P.ffn_w_out + (size_t)w * FF * DM, FF, DM, (bf16*)(ws + WS_WFOUT) + (size_t)w * DM * FF, nullptr, false, scr, r % I_FOUT, lane); continue; } r -= 4 * I_FOUT;
        if (r < I_AIN) { p0_item(P.attn_w_in, DM, AIN, (bf16*)(ws + WS_WAIN), P.norm_g + (0 * 3 + 1) * DM, false, scr, r, lane); continue; } r -= I_AIN;
        if (r < I_O) { p0_item(P.attn_w_out, DM, DM, (bf16*)(ws + WS_WAOUT), nullptr, false, scr, r, lane); continue; } r -= I_O;
        if (r < I_RIN) { p0_item(P.rec_w_in, DM, RIN, (bf16*)(ws + WS_WRIN), P.norm_g + (1 * 3 + 1) * DM, false, scr, r, lane); continue; } r -= I_RIN;
        p0_item(P.rec_w_out, DM, DM, (bf16*)(ws + WS_WROUT), nullptr, false, scr, r, lane);
    }
    bf16* hb = (bf16*)(ws + WS_HB); float* part = (float*)(ws + WS_PART);
    for (int m = gw; m < M; m += NGW) {
        const GAS f32x4* xr = (const GAS f32x4*)(P.x + (size_t)m * DM) + lane;
        f32x4 v[4]; float s = 0.f;
#pragma unroll
        for (int j = 0; j < 4; ++j) { v[j] = xr[64 * j]; s += (v[j].x * v[j].x + v[j].y * v[j].y) + (v[j].z * v[j].z + v[j].w * v[j].w); }
        s = wave_sum(s);
        GAS unsigned long long* o8 = (GAS unsigned long long*)(hb + (size_t)m * DM) + lane;
#pragma unroll
        for (int j = 0; j < 4; ++j) o8[64 * j] = (unsigned long long)pk2(v[j].x, v[j].y) | ((unsigned long long)pk2(v[j].z, v[j].w) << 32);
        if (lane < 16) part[(size_t)m * 16 + lane] = lane == 0 ? s : 0.f;
    }
}

__device__ __forceinline__ void final_norm(const Ptrs& P, int wave, int lane) {
    const int gw = blockIdx.x * NWAVES + wave, NGW = gridDim.x * NWAVES;
    f32x4 g[4];
#pragma unroll
    for (int j = 0; j < 4; ++j) g[j] = ((const f32x4*)P.final_g)[lane + 64 * j];
    for (int m = gw; m < M; m += NGW) {
        GAS f32x4* xr = (GAS f32x4*)(P.out + (size_t)m * DM) + lane;
        f32x4 v[4]; float s = 0.f;
#pragma unroll
        for (int j = 0; j < 4; ++j) { v[j] = xr[64 * j]; s += (v[j].x * v[j].x + v[j].y * v[j].y) + (v[j].z * v[j].z + v[j].w * v[j].w); }
        const float r = 1.0f / sqrtf(wave_sum(s) * (1.0f / DM) + pg8::RMS_EPS);
#pragma unroll
        for (int j = 0; j < 4; ++j) xr[64 * j] = v[j] * r * g[j];
    }
}

constexpr int VSTR = 80;
constexpr int VT_BYTES = 64 * VSTR;
__device__ __forceinline__ void stage_vt(LAS unsigned char* vt, const bf16* vsrc, int pitch, int lane) {
    bf16x8 v[4];
#pragma unroll
    for (int i = 0; i < 4; ++i) v[i] = *(const bf16x8*)(vsrc + (size_t)(i * 8 + (lane >> 3)) * pitch + 8 * (lane & 7));
#pragma unroll
    for (int i = 0; i < 4; ++i) { const int kk = i * 8 + (lane >> 3), p = (kk & 16) | swap23(kk & 15), c = lane & 7;
#pragma unroll
        for (int j = 0; j < 8; ++j) *(LAS short*)(vt + (8 * c + j) * VSTR + 2 * p) = v[i][j]; }
}
__device__ __forceinline__ bf16x8 read_vt(const LAS unsigned char* vt, int d, int s2, int h) { return *(const LAS bf16x8*)(vt + d * VSTR + 32 * s2 + 16 * h); }

__device__ __forceinline__ void swa_unit(const bf16* qkv, bf16* obuf, const float* sinks, int b, int hq, int qb, LAS unsigned char* vt, int lane) {
    const int c = lane & 31, hi = lane >> 5, kvh = hq >> 2;
    const size_t rowbase = (size_t)b * SEQ;
    const bf16* qp = qkv + (rowbase + qb * 32 + c) * AIN + hq * 64 + 8 * hi;
    bf16x8 qf[4];
#pragma unroll
    for (int st = 0; st < 4; ++st) qf[st] = *(const bf16x8*)(qp + 16 * st);
    const float slope = exp2f(-(float)(hq + 1)), sink = sinks[hq];
    f32x16 X[5]; float mx = -INFINITY;
#pragma unroll
    for (int i = 0; i < 5; ++i) { const int kb = qb - 4 + i;
        f32x16 a;
#pragma unroll
        for (int r = 0; r < 16; ++r) a[r] = 0.f;
        if (kb >= 0) {
            const bf16* kp = qkv + (rowbase + kb * 32 + c) * AIN + 512 + kvh * 64 + 8 * hi;
#pragma unroll
            for (int st = 0; st < 4; ++st) a = MFMA32(*(const bf16x8*)(kp + 16 * st), qf[st], a);
#pragma unroll
            for (int r = 0; r < 16; ++r) { const int dist = (qb * 32 + c) - (kb * 32 + crow(r, hi)); const bool valid = dist >= 0 && dist < 128;
                const float s = valid ? a[r] * 0.125f - slope * (float)dist : -INFINITY; a[r] = s; mx = fmaxf(mx, s); }
        } else {
#pragma unroll
            for (int r = 0; r < 16; ++r) a[r] = -INFINITY;
        }
        X[i] = a; }
    mx = fmaxf(mx, __shfl_xor(mx, 32)); mx = fmaxf(mx, sink);
    float sum = 0.f;
#pragma unroll
    for (int i = 0; i < 5; ++i)
#pragma unroll
        for (int r = 0; r < 16; ++r) { const float p = __expf(X[i][r] - mx); X[i][r] = p; sum += p; }
    sum += __shfl_xor(sum, 32);
    const float inv = 1.0f / (sum + __expf(sink - mx));
    f32x16 O0, O1;
#pragma unroll
    for (int r = 0; r < 16; ++r) { O0[r] = 0.f; O1[r] = 0.f; }
#pragma unroll
    for (int i = 0; i < 5; ++i) { const int kb = qb - 4 + i;
        if (kb >= 0) {
            stage_vt(vt, qkv + (rowbase + kb * 32) * AIN + 640 + kvh * 64, AIN, lane);
#pragma unroll
            for (int s2 = 0; s2 < 2; ++s2) {
                const bf16x8 pf = packf8(X[i][8 * s2 + 0] * inv, X[i][8 * s2 + 1] * inv, X[i][8 * s2 + 2] * inv, X[i][8 * s2 + 3] * inv, X[i][8 * s2 + 4] * inv, X[i][8 * s2 + 5] * inv, X[i][8 * s2 + 6] * inv, X[i][8 * s2 + 7] * inv);
                O0 = MFMA32(pf, read_vt(vt, c, s2, hi), O0); O1 = MFMA32(pf, read_vt(vt, c + 32, s2, hi), O1); }
        } }
    bf16* op = obuf + (rowbase + qb * 32) * DM + hq * 64 + c;
#pragma unroll
    for (int r = 0; r < 16; ++r) { const size_t ro = (size_t)crow(r, hi) * DM; op[ro] = (bf16)f2bf(O0[r]); op[ro + 32] = (bf16)f2bf(O1[r]); }
}

__device__ __forceinline__ void sb_unit(const bf16* qkv, bf16* obuf, int b, int h, int qb, LAS unsigned char* vt, int lane) {
    const int c = lane & 31, hi = lane >> 5, t = qb * 32 + c;
    const size_t rowbase = (size_t)b * SEQ;
    const bf16* qp = qkv + (rowbase + t) * AIN + 768 + h * 64 + 8 * hi;
    bf16x8 qf[4];
#pragma unroll
    for (int st = 0; st < 4; ++st) qf[st] = *(const bf16x8*)(qp + 16 * st);
    float carry = 0.f;
    f32x16 O0, O1;
#pragma unroll
    for (int r = 0; r < 16; ++r) { O0[r] = 0.f; O1[r] = 0.f; }
    for (int kb = qb; kb >= 0; --kb) {
        const bf16* kp = qkv + (rowbase + kb * 32 + c) * AIN + 1280 + h * 64 + 8 * hi;
        f32x16 a;
#pragma unroll
        for (int r = 0; r < 16; ++r) a[r] = 0.f;
#pragma unroll
        for (int st = 0; st < 4; ++st) a = MFMA32(*(const bf16x8*)(kp + 16 * st), qf[st], a);
        float lk[16], lsg[16];
#pragma unroll
        for (int r = 0; r < 16; ++r) { const float z = a[r] * 0.125f; const bool causal = (kb * 32 + crow(r, hi)) < t;
            const float sp = fmaxf(z, 0.f) + __logf(1.0f + __expf(-fabsf(z)));
            lk[r] = causal ? -sp : 0.f; lsg[r] = z - sp; }
        float G[4], Gp[4];
#pragma unroll
        for (int g = 0; g < 4; ++g) { G[g] = (lk[4 * g] + lk[4 * g + 1]) + (lk[4 * g + 2] + lk[4 * g + 3]); Gp[g] = __shfl_xor(G[g], 32); }
        float tail = 0.f; f32x16 w;
#pragma unroll
        for (int g = 3; g >= 0; --g) { const float base = carry + tail + (hi == 0 ? Gp[g] : 0.f); float run = 0.f;
#pragma unroll
            for (int i = 3; i >= 0; --i) { const int r = 4 * g + i; const bool causal = (kb * 32 + crow(r, hi)) < t;
                w[r] = causal ? __expf(lsg[r] + base + run) : 0.f; run += lk[r]; }
            tail += G[g] + Gp[g]; }
        carry += tail;
        stage_vt(vt, qkv + (rowbase + kb * 32) * AIN + 1792 + h * 64, AIN, lane);
#pragma unroll
        for (int s2 = 0; s2 < 2; ++s2) {
            const bf16x8 pf = packf8(w[8 * s2 + 0], w[8 * s2 + 1], w[8 * s2 + 2], w[8 * s2 + 3], w[8 * s2 + 4], w[8 * s2 + 5], w[8 * s2 + 6], w[8 * s2 + 7]);
            O0 = MFMA32(pf, read_vt(vt, c, s2, hi), O0); O1 = MFMA32(pf, read_vt(vt, c + 32, s2, hi), O1); }
        if (__all(carry < SB_EXIT)) break;
    }
    bf16* op = obuf + (rowbase + qb * 32) * DM + 512 + h * 64 + c;
#pragma unroll
    for (int r = 0; r < 16; ++r) { const size_t ro = (size_t)crow(r, hi) * DM; op[ro] = (bf16)f2bf(O0[r]); op[ro + 32] = (bf16)f2bf(O1[r]); }
}

__device__ __forceinline__ void attn_phase(const Ptrs& P, LAS unsigned char* lds, int wave, int lane) {
    const bf16* qkv = (const bf16*)(P.ws + WS_ACT); bf16* obuf = (bf16*)(P.ws + WS_OB);
    LAS unsigned char* vt = lds + RING_OFF + wave * 8192;
    const int gw = blockIdx.x * NWAVES + wave, NGW = gridDim.x * NWAVES;
    constexpr int NU = BATCH * 8 * (SEQ / 32);
    for (int u = gw; u < 2 * NU; u += NGW) {
        if (u < NU) { const int qb = (SEQ / 32 - 1) - (u >> 6), bh = u & 63; sb_unit(qkv, obuf, bh >> 3, bh & 7, qb, vt, lane); }
        else { const int v = u - NU, qb = v >> 6, bh = v & 63; swa_unit(qkv, obuf, P.attn_sinks, bh >> 3, bh & 7, qb, vt, lane); }
    }
}

constexpr int KSTR = 144;
constexpr int QSTR = 272;
constexpr int OSTR = 132;
constexpr int L_TOT = 0, L_GL = 2048, L_KS = L_GL + 64 * OSTR * 4, L_VT = L_KS + 128 * KSTR, L_A_END = L_VT + 128 * KSTR;
constexpr int L_QI = L_KS, L_QX = L_QI + 64 * QSTR, L_KX = L_QX + 64 * QSTR, L_VT2 = L_KX + 64 * QSTR, L_OF = L_GL, L_RS = L_VT2 + 128 * KSTR, L_C_END = L_RS + 256;
static_assert(L_A_END <= RING_BYTES && L_C_END <= RING_BYTES, "HGRN2 LDS map");

__device__ __forceinline__ float hgrn_lb(const float* logits, int col) {
    const float l0 = logits[col], l1 = logits[512 + col]; return 1.0f / (1.0f + __expf(l0 - l1));
}
__device__ __forceinline__ void hgrn_gates(const bf16* qkv, size_t row0, int hh, int d, int tq, float lbv, LAS float* tot, LAS float* GL) {
    float cum = 0.f;
    const bf16* zp = qkv + (row0 + tq * 16) * RIN + 512 + hh * 128 + d;
#pragma unroll 4
    for (int j = 0; j < 16; ++j) { const float z = bf2f(zp[(size_t)j * RIN]);
        const float sg = 1.0f / (1.0f + __expf(-z)); cum += __logf(lbv + (1.0f - lbv) * sg); GL[(tq * 16 + j) * 128 + d] = cum; }
    tot[tq * 128 + d] = cum;
    __syncthreads();
}

__device__ __forceinline__ void rec_pass_a(const Ptrs& P, LAS unsigned char* lds, int wave, int lane) {
    const bf16* qkv = (const bf16*)(P.ws + WS_ACT); bf16* obuf = (bf16*)(P.ws + WS_OB);
    float* st = (float*)(P.ws + WS_ST); float* dec = (float*)(P.ws + WS_DEC);
    const int tid = threadIdx.x, d = tid & 127, tq = tid >> 7, c = lane & 31, hi = lane >> 5;
    LAS float* tot = (LAS float*)(lds + L_TOT); LAS float* GL = (LAS float*)(lds + L_GL);
    for (int u = blockIdx.x; u < 1024; u += gridDim.x) {
        const int b = u >> 7, hh = (u >> 5) & 3, ch = u & 31; const size_t row0 = (size_t)b * SEQ + ch * 64;
        const float lbv = hgrn_lb(P.lb_logits, hh * 128 + d);
        hgrn_gates(qkv, row0, hh, d, tq, lbv, tot, GL);
        float off = 0.f;
#pragma unroll
        for (int q = 0; q < 3; ++q) off += (q < tq) ? tot[q * 128 + d] : 0.f;
        const float glast = tot[d] + tot[128 + d] + tot[256 + d] + tot[384 + d];
        if (tq == 0) dec[u * 128 + d] = __expf(glast);
#pragma unroll 1
        for (int grp = 0; grp < 2; ++grp) {
            const bf16* zp = qkv + (row0 + tq * 16 + grp * 8) * RIN + 512 + hh * 128 + d;
            float ks[8]; bf16x8 vv;
#pragma unroll
            for (int j = 0; j < 8; ++j) { const float z = bf2f(zp[(size_t)j * RIN]); const float g = GL[(tq * 16 + grp * 8 + j) * 128 + d] + off;
                ks[j] = (1.0f - lbv) / (1.0f + __expf(z)) * __expf(glast - g); vv[j] = (short)zp[(size_t)j * RIN + 512]; }
            *(LAS bf16x8*)(lds + L_KS + d * KSTR + tq * 32 + grp * 16) = packf8(ks[0], ks[1], ks[2], ks[3], ks[4], ks[5], ks[6], ks[7]);
            *(LAS bf16x8*)(lds + L_VT + d * KSTR + tq * 32 + grp * 16) = vv;
        }
        __syncthreads();
        const int eb = wave >> 1;
#pragma unroll
        for (int dbi = 0; dbi < 2; ++dbi) { const int db = 2 * (wave & 1) + dbi;
            f32x16 acc;
#pragma unroll
            for (int r = 0; r < 16; ++r) acc[r] = 0.f;
#pragma unroll
            for (int s = 0; s < 4; ++s) acc = MFMA32(*(const LAS bf16x8*)(lds + L_VT + (eb * 32 + c) * KSTR + 32 * s + 16 * hi), *(const LAS bf16x8*)(lds + L_KS + (db * 32 + c) * KSTR + 32 * s + 16 * hi), acc);
            float* sp = st + ((size_t)u * 128 + eb * 32) * 128 + db * 32 + c;
#pragma unroll
            for (int r = 0; r < 16; ++r) sp[(size_t)crow(r, hi) * 128] = acc[r]; }
        __syncthreads();
    }
    const int gid = blockIdx.x * (NWAVES * 64) + tid, NT = gridDim.x * NWAVES * 64;
    for (int it = gid; it < M * 64; it += NT) {
        const int row = it >> 6, c8 = (it & 63) * 8, t = row & (SEQ - 1);
        const bf16* rp = qkv + (size_t)row * RIN;
        const bf16x8 gb = *(const bf16x8*)(rp + 2048 + c8), gc0 = *(const bf16x8*)(rp + 2560 + c8), u0 = *(const bf16x8*)(rp + 3072 + c8);
        bf16x8 gc1, u1, gc2, u2;
#pragma unroll
        for (int j = 0; j < 8; ++j) { gc1[j] = 0; u1[j] = 0; gc2[j] = 0; u2[j] = 0; }
        if (t >= 1) { gc1 = *(const bf16x8*)(rp - RIN + 2560 + c8); u1 = *(const bf16x8*)(rp - RIN + 3072 + c8); }
        if (t >= 2) { gc2 = *(const bf16x8*)(rp - 2 * RIN + 2560 + c8); u2 = *(const bf16x8*)(rp - 2 * RIN + 3072 + c8); }
        float o[8];
#pragma unroll
        for (int j = 0; j < 8; ++j) { const float w0 = P.conv_w[c8 + j], w1 = P.conv_w[512 + c8 + j], w2 = P.conv_w[1024 + c8 + j];
            const float x0 = bf2f((unsigned short)gc0[j]) * bf2f((unsigned short)u0[j]), x1 = bf2f((unsigned short)gc1[j]) * bf2f((unsigned short)u1[j]), x2 = bf2f((unsigned short)gc2[j]) * bf2f((unsigned short)u2[j]);
            o[j] = bf2f((unsigned short)gb[j]) * (w0 * x2 + w1 * x1 + w2 * x0); }
        *(bf16x8*)(obuf + (size_t)row * DM + 512 + c8) = packf8(o[0], o[1], o[2], o[3], o[4], o[5], o[6], o[7]);
    }
}

__device__ __forceinline__ void rec_pass_b(const Ptrs& P) {
    const float* st = (const float*)(P.ws + WS_ST); const float* dec = (const float*)(P.ws + WS_DEC); bf16* sb = (bf16*)(P.ws + WS_HB);
    const int gid = blockIdx.x * (NWAVES * 64) + threadIdx.x, NT = gridDim.x * NWAVES * 64;
    for (int x = gid; x < 32 * 16384; x += NT) {
        const int seq = x >> 14, ed = x & 16383, d = ed & 127; float S = 0.f;
#pragma unroll 2
        for (int ch = 0; ch < 32; ++ch) { const size_t u = (size_t)seq * 32 + ch;
            const float kv = st[u * 16384 + ed], dc = dec[u * 128 + d];
            sb[u * 16384 + ed] = (bf16)f2bf(S); S = dc * S + kv; }
    }
}

__device__ __forceinline__ void rec_pass_c(const Ptrs& P, LAS unsigned char* lds, int wave, int lane) {
    const bf16* qkv = (const bf16*)(P.ws + WS_ACT); bf16* obuf = (bf16*)(P.ws + WS_OB); const bf16* sb = (const bf16*)(P.ws + WS_HB);
    const int tid = threadIdx.x, d = tid & 127, tq = tid >> 7, c = lane & 31, hi = lane >> 5;
    LAS float* tot = (LAS float*)(lds + L_TOT); LAS float* GL = (LAS float*)(lds + L_GL); LAS float* OF = (LAS float*)(lds + L_OF); LAS float* RS = (LAS float*)(lds + L_RS);
    for (int u = blockIdx.x; u < 1024; u += gridDim.x) {
        const int b = u >> 7, hh = (u >> 5) & 3, ch = u & 31; const size_t row0 = (size_t)b * SEQ + ch * 64;
        const float lbv = hgrn_lb(P.lb_logits, hh * 128 + d);
        hgrn_gates(qkv, row0, hh, d, tq, lbv, tot, GL);
        float off = 0.f;
#pragma unroll
        for (int q = 0; q < 3; ++q) off += (q < tq) ? tot[q * 128 + d] : 0.f;
        const float gref = tot[d] + tot[128 + d];
        {   const bf16* qp = qkv + (row0 + tq * 16) * RIN + hh * 128 + d;
#pragma unroll 4
            for (int j = 0; j < 16; ++j) { const int t = tq * 16 + j;
                const float qv = bf2f(qp[(size_t)j * RIN]), z = bf2f(qp[(size_t)j * RIN + 512]), g = GL[t * 128 + d] + off, sq = pg8::silu_f(qv);
                const float kx = (1.0f - lbv) / (1.0f + __expf(z)) * __expf(fminf(gref - g, 80.f));
                *(LAS unsigned short*)(lds + L_QI + t * QSTR + 2 * d) = (unsigned short)f2bf(sq * __expf(g));
                *(LAS unsigned short*)(lds + L_QX + t * QSTR + 2 * d) = (unsigned short)f2bf(sq * __expf(fminf(g - gref, 80.f)));
                *(LAS unsigned short*)(lds + L_KX + t * QSTR + 2 * d) = (unsigned short)f2bf(kx); }
#pragma unroll 1
            for (int grp = 0; grp < 2; ++grp) { bf16x8 vv;
#pragma unroll
                for (int k = 0; k < 8; ++k) { const int j = (k & 3) + 8 * (k >> 2) + 4 * grp; vv[k] = (short)qp[(size_t)j * RIN + 1024]; }
                *(LAS bf16x8*)(lds + L_VT2 + d * KSTR + tq * 32 + grp * 16) = vv; }
        }
        __syncthreads();
        const int tb = wave & 1, eb = wave >> 1;
        f32x16 acc;
#pragma unroll
        for (int r = 0; r < 16; ++r) acc[r] = 0.f;
        const bf16* sp = sb + ((size_t)u * 128 + eb * 32 + c) * 128 + 8 * hi;
#pragma unroll
        for (int s = 0; s < 8; ++s) acc = MFMA32(*(const LAS bf16x8*)(lds + L_QI + (tb * 32 + c) * QSTR + 32 * s + 16 * hi), *(const bf16x8*)(sp + 16 * s), acc);
        for (int sbk = 0; sbk <= tb; ++sbk) {
            f32x16 X;
#pragma unroll
            for (int r = 0; r < 16; ++r) X[r] = 0.f;
#pragma unroll
            for (int s = 0; s < 8; ++s) X = MFMA32(*(const LAS bf16x8*)(lds + L_KX + (sbk * 32 + c) * QSTR + 32 * s + 16 * hi), *(const LAS bf16x8*)(lds + L_QX + (tb * 32 + c) * QSTR + 32 * s + 16 * hi), X);
#pragma unroll
            for (int r = 0; r < 16; ++r) X[r] = (sbk * 32 + crow(r, hi) <= tb * 32 + c) ? X[r] : 0.f;
#pragma unroll
            for (int s2 = 0; s2 < 2; ++s2) {
                const bf16x8 pf = packf8(X[8 * s2 + 0], X[8 * s2 + 1], X[8 * s2 + 2], X[8 * s2 + 3], X[8 * s2 + 4], X[8 * s2 + 5], X[8 * s2 + 6], X[8 * s2 + 7]);
                acc = MFMA32(pf, *(const LAS bf16x8*)(lds + L_VT2 + (eb * 32 + c) * KSTR + sbk * 64 + 32 * s2 + 16 * hi), acc); }
        }
#pragma unroll
        for (int r = 0; r < 16; ++r) OF[(tb * 32 + crow(r, hi)) * OSTR + eb * 32 + c] = acc[r];
        __syncthreads();
        { const int t = tid >> 3, pt = tid & 7; float ss = 0.f;
#pragma unroll
            for (int k = 0; k < 16; ++k) { const float v = OF[t * OSTR + pt * 16 + k]; ss += v * v; }
            ss += __shfl_xor(ss, 1); ss += __shfl_xor(ss, 2); ss += __shfl_xor(ss, 4);
            if (pt == 0) RS[t] = 1.0f / sqrtf(ss * (1.0f / 128.0f) + pg8::RMS_EPS); }
        __syncthreads();
        const float gn = P.hgrn_norm_g[d];
#pragma unroll 4
        for (int j = 0; j < 16; ++j) { const int t = tq * 16 + j;
            const float gate = bf2f(qkv[(row0 + t) * RIN + 1536 + hh * 128 + d]);
            obuf[(row0 + t) * DM + hh * 128 + d] = (bf16)f2bf(OF[t * OSTR + d] * RS[t] * gn * pg8::silu_f(gate)); }
        __syncthreads();
    }
}

constexpr int N_PHASES = 18;
struct Args { Ptrs p; int ph_lo, ph_hi; };
__global__ void __launch_bounds__(NWAVES * 64, 2) trunk_fwd(Args args) {
    extern __shared__ __attribute__((aligned(16))) unsigned char lds_raw[];
    LAS unsigned char* lds = (LAS unsigned char*)lds_raw;
    volatile LAS unsigned* MISC = (volatile LAS unsigned*)(lds + MISC_OFF);
    const int tid = threadIdx.x, lane = tid & 63, wave = __builtin_amdgcn_readfirstlane(tid >> 6);
    const Ptrs& P = args.p;
    unsigned char* ws = P.ws;
    gu32* ctl = (gu32*)(ws + WS_CTL);
    for (int u = tid; u < (LDS_BYTES - LDSCTL_OFF) / 4; u += NWAVES * 64) ((LAS unsigned*)(lds + LDSCTL_OFF))[u] = 0u;
    __syncthreads();
    const int lo = args.ph_lo, hi = args.ph_hi;
    XcdBarrier bar; bar.bar = (unsigned*)(ctl + CW_BAR); bar.x = 0; bar.st = nullptr;
    if (hi - lo > 1) bar = xcd_barrier_post((unsigned*)(ctl + CW_BAR), MISC + 8);
#define IN(k) (lo <= (k) && (k) < hi)
#define SEAM(k) do { if (IN(k) && IN((k) + 1)) xcd_barrier(bar); } while (0)
    bf16* hb = (bf16*)(ws + WS_HB); bf16* ob = (bf16*)(ws + WS_OB); bf16* act = (bf16*)(ws + WS_ACT); float* part = (float*)(ws + WS_PART);
    const int G = gridDim.x, bx = blockIdx.x;

    if (IN(0)) { p0_prologue(P, lds, wave, lane); } SEAM(0);
#define WFIN(i) ((const bf16*)(ws + WS_WFIN) + (size_t)(i) * 2 * FF * DM)
#define WFOUT(i) ((const bf16*)(ws + WS_WFOUT) + (size_t)(i) * DM * FF)
#define PH_FFN_IN(k, wi) do { if (IN(k)) { pg8::Gemm g{hb, WFIN(wi), M, 2 * FF, DM}; pg8::StaticOrder S; S.init(M, 2 * FF, G, bx); \
        pg8::EpiSwiglu E{act, FF, part}; pg8::gemm_phase<pg8::EpiSwiglu, pg8::StaticOrder, true, true>(lds + RING_OFF, g, S, E); } SEAM(k); } while (0)
#define PH_FFN_OUT(k, wi, basep) do { if (IN(k)) { pg8::Gemm g{act, WFOUT(wi), M, DM, FF}; pg8::StaticOrder S; S.init(M, DM, G, bx); \
        pg8::EpiResid E{basep, P.out, hb, part, 0.5f}; pg8::gemm_phase<pg8::EpiResid, pg8::StaticOrder, true, true>(lds + RING_OFF, g, S, E); } SEAM(k); } while (0)
#define PH_MIX_IN(k, woff, NN) do { if (IN(k)) { pg8::Gemm g{hb, (const bf16*)(ws + (woff)), M, NN, DM}; pg8::StaticOrder S; S.init(M, NN, G, bx); \
        pg8::EpiRowScale E{act, NN, part}; pg8::gemm_phase<pg8::EpiRowScale, pg8::StaticOrder, true, true>(lds + RING_OFF, g, S, E); } SEAM(k); } while (0)
#define PH_MIX_OUT(k, woff) do { if (IN(k)) { pg8::Gemm g{ob, (const bf16*)(ws + (woff)), M, DM, DM}; pg8::StaticOrder S; S.init(M, DM, G, bx); \
        pg8::EpiResid E{P.out, P.out, hb, part, 1.0f}; pg8::gemm_phase<pg8::EpiResid, pg8::StaticOrder, true, true>(lds + RING_OFF, g, S, E); } SEAM(k); } while (0)
    PH_FFN_IN(1, 0); PH_FFN_OUT(2, 0, P.x);
    PH_MIX_IN(3, WS_WAIN, AIN);
    if (IN(4)) { attn_phase(P, lds, wave, lane); } SEAM(4);
    PH_MIX_OUT(5, WS_WAOUT);
    PH_FFN_IN(6, 1); PH_FFN_OUT(7, 1, P.out);
    PH_FFN_IN(8, 2); PH_FFN_OUT(9, 2, P.out);
    PH_MIX_IN(10, WS_WRIN, RIN);
    if (IN(11)) { rec_pass_a(P, lds, wave, lane); } SEAM(11);
    if (IN(12)) { rec_pass_b(P); } SEAM(12);
    if (IN(13)) { rec_pass_c(P, lds, wave, lane); } SEAM(13);
    PH_MIX_OUT(14, WS_WROUT);
    PH_FFN_IN(15, 3); PH_FFN_OUT(16, 3, P.out);
    if (IN(N_PHASES - 1)) final_norm(P, wave, lane);
#undef IN
#undef SEAM
}

#ifndef MK_PER_PHASE
#define MK_PER_PHASE 1
#endif
extern "C" void kernel_launch(void* const* d_in, const int* in_sizes, int n_in, void* d_out, int out_size, void* d_ws, size_t ws_size, hipStream_t stream) {
    static int grid = 0;
    if (grid == 0) {
        if (n_in != 13 || in_sizes[0] != M * DM || out_size != M * DM || ws_size < WS_END) { fprintf(stderr, "kernel_launch: unexpected shapes (n_in %d, in0 %d, out %d, ws %zu); nothing launched\n", n_in, n_in > 0 ? in_sizes[0] : -1, out_size, ws_size); grid = -1; return; }
        int dev = 0, cus = 0, per_cu = 0;
        if (hipGetDevice(&dev) != hipSuccess || hipDeviceGetAttribute(&cus, hipDeviceAttributeMultiprocessorCount, dev) != hipSuccess) { grid = -1; return; }
        if (hipFuncSetAttribute((const void*)trunk_fwd, hipFuncAttributeMaxDynamicSharedMemorySize, LDS_BYTES) != hipSuccess) { fprintf(stderr, "kernel_launch: hipFuncSetAttribute failed\n"); grid = -1; return; }
        if (hipOccupancyMaxActiveBlocksPerMultiprocessor(&per_cu, (const void*)trunk_fwd, NWAVES * 64, LDS_BYTES) != hipSuccess || per_cu < 1) { fprintf(stderr, "kernel_launch: occupancy query says %d blocks per CU\n", per_cu); per_cu = 1; }
        (void)hipGetLastError();
        grid = cus;
    }
    if (grid < 0) return;
    (void)hipMemsetAsync((char*)d_ws + WS_CTL, 0, CTL_ZERO_BYTES, stream);
    Args a{};
    const float** pp = (const float**)&a.p;
    for (int i = 0; i < 13; ++i) pp[i] = (const float*)d_in[i];
    a.p.out = (float*)d_out; a.p.ws = (unsigned char*)d_ws;
#if MK_PER_PHASE
    for (int k = 0; k < N_PHASES; ++k) { a.ph_lo = k; a.ph_hi = k + 1; hipLaunchKernelGGL(trunk_fwd, dim3(grid), dim3(NWAVES * 64), LDS_BYTES, stream, a); }
#else
    a.ph_lo = 0; a.ph_hi = N_PHASES; hipLaunchKernelGGL(trunk_fwd, dim3(grid), dim3(NWAVES * 64), LDS_BYTES, stream, a);
#endif
}
```

```cpp
#include <hip/hip_runtime.h>
#include <cstdio>
#include <cstdint>
namespace pg8 {
#define PG8_LAS __attribute__((address_space(3)))
typedef unsigned short bf16_t;
typedef short bf16x8 __attribute__((ext_vector_type(8)));
typedef float f32x4 __attribute__((ext_vector_type(4)));
typedef unsigned u32x4 __attribute__((ext_vector_type(4)));
constexpr int BM = 256, BK = 64, HALF = 128, HTB = HALF * BK * 2  , STAGE_BYTES = 8 * HTB, NXCD = 8, WGM = 8;

__host__ __device__ __forceinline__ int lds_byte(int r, int c) { const int st = (r >> 4) * 2 + (c >> 5), rr = r & 15, cc = c & 31, ob = rr * 64 + cc * 2; return st * 1024 + (ob ^ (((ob >> 9) & 1) << 5)); }
__host__ __device__ __forceinline__ void stage_rc(int b, int& R, int& C) { const int st = b / 1024, sb = b % 1024, swz = sb ^ (((sb >> 9) & 1) << 5); R = (st >> 1) * 16 + swz / 64; C = (st & 1) * 32 + (swz % 64) / 2; }
__host__ __device__ __forceinline__ int perm32(int rho) { const int n = rho >> 4, i = rho & 15; return 8 * (i >> 2) + 4 * n + (i & 3); }

struct Unit { int pm, pn; };
struct Gemm { const bf16_t* A; const bf16_t* Bt; int M, N, K; };

struct StaticOrder {
    int nM, nN, nwg, G, c;
    __host__ __device__ void init(int M, int N, int G_, int c_) { nM = M / BM; nN = N / BM; nwg = nM * nN; G = G_; c = c_; }
    __host__ __device__ bool next(int i, Unit& u) const {
        const long L = (long)i * G + c; if (L >= nwg) return false;
        int wgid = (int)L; { const int q = nwg / NXCD, r = nwg % NXCD, xcd = wgid % NXCD, off = wgid / NXCD; wgid = (xcd < r ? xcd * (q + 1) : r * (q + 1) + (xcd - r) * q) + off; }
        const int nig = WGM * nN, gid = wgid / nig, fm = gid * WGM, gsz = (nM - fm) < WGM ? (nM - fm) : WGM;
        u.pm = fm + ((wgid % nig) % gsz); u.pn = (wgid % nig) / gsz; return true;
    }
    __device__ __forceinline__ void a_ready(const Unit&) const {}
    __device__ __forceinline__ void done(const Unit&) const {}
};
typedef float f32x2_t __attribute__((ext_vector_type(2))); typedef __bf16 bf16x2_t __attribute__((ext_vector_type(2)));
__device__ __forceinline__ unsigned cvt_pk_bf16(float lo, float hi) { f32x2_t v = {lo, hi}; bf16x2_t b = __builtin_convertvector(v, bf16x2_t); return __builtin_bit_cast(unsigned, b); }
__device__ __forceinline__ u32x4 pack8(const f32x4 a, const f32x4 b) { u32x4 w; w.x = cvt_pk_bf16(a[0], a[1]); w.y = cvt_pk_bf16(a[2], a[3]); w.z = cvt_pk_bf16(b[0], b[1]); w.w = cvt_pk_bf16(b[2], b[3]); return w; }
constexpr float RMS_EPS = 1e-6f;
__device__ __forceinline__ float row_rstd(const float* part, int row, int fq) {
    const f32x4 p = *(const f32x4*)(part + (size_t)row * 16 + fq * 4);
    float s = (p[0] + p[1]) + (p[2] + p[3]);
    s += __shfl_xor(s, 16); s += __shfl_xor(s, 32);
    return 1.0f / sqrtf(s * (1.0f / 1024.0f) + RMS_EPS);
}
__device__ __forceinline__ float silu_f(float x) { return x * __builtin_amdgcn_rcpf(1.0f + __expf(-x)); }
struct EpiRowScale {
    static constexpr bool PERM = true, AFTER_DRAIN = false;
    bf16_t* O; int ldc; const float* part;
    __device__ __forceinline__ void operator()(const f32x4 (&acc)[2][2][4][2], const Unit& u, int wr, int wc, int fr, int fq) const {
        const int row0 = u.pm * BM + wr * 64 + fr, col0 = u.pn * BM + wc * 32 + 8 * fq;
#pragma unroll
        for (int ai = 0; ai < 2; ++ai)
#pragma unroll
            for (int m = 0; m < 4; ++m) { const int row = row0 + ai * HALF + m * 16; const float r = row_rstd(part, row, fq);
                bf16_t* rowp = O + (size_t)row * ldc + col0;
#pragma unroll
                for (int bj = 0; bj < 2; ++bj) *(u32x4*)(rowp + bj * HALF) = pack8(acc[ai][bj][m][0] * r, acc[ai][bj][m][1] * r);
                asm volatile("" ::: "memory"); }
    }
};
struct EpiSwiglu {
    static constexpr bool PERM = true, AFTER_DRAIN = false;
    bf16_t* O; int ldc; const float* part;
    __device__ __forceinline__ void operator()(const f32x4 (&acc)[2][2][4][2], const Unit& u, int wr, int wc, int fr, int fq) const {
        const int row0 = u.pm * BM + wr * 64 + fr, col0 = u.pn * HALF + wc * 32 + 8 * fq;
#pragma unroll
        for (int ai = 0; ai < 2; ++ai)
#pragma unroll
            for (int m = 0; m < 4; ++m) { const int row = row0 + ai * HALF + m * 16; const float r = row_rstd(part, row, fq);
                f32x4 o[2];
#pragma unroll
                for (int n = 0; n < 2; ++n) { const f32x4 g = acc[ai][0][m][n] * r, up = acc[ai][1][m][n] * r;
#pragma unroll
                    for (int i = 0; i < 4; ++i) o[n][i] = silu_f(g[i]) * up[i]; }
                *(u32x4*)(O + (size_t)row * ldc + col0) = pack8(o[0], o[1]);
                asm volatile("" ::: "memory"); }
    }
};
__device__ __forceinline__ f32x4 bf2x_lo(unsigned a, unsigned b) { f32x4 r; r[0] = __uint_as_float(a << 16); r[1] = __uint_as_float(a & 0xffff0000u); r[2] = __uint_as_float(b << 16); r[3] = __uint_as_float(b & 0xffff0000u); return r; }
struct EpiResid {
    static constexpr bool PERM = true, AFTER_DRAIN = false;
    const bf16_t* base; bf16_t* ob; float* part; float scale;
    __device__ __forceinline__ void operator()(const f32x4 (&acc)[2][2][4][2], const Unit& u, int wr, int wc, int fr, int fq) const {
        const int row0 = u.pm * BM + wr * 64 + fr, col0 = u.pn * BM + wc * 32 + 8 * fq;
#pragma unroll
        for (int ai = 0; ai < 2; ++ai)
#pragma unroll
            for (int m = 0; m < 4; ++m) { const int row = row0 + ai * HALF + m * 16; const size_t off = (size_t)row * 1024 + col0; float ss = 0.f;
#pragma unroll
                for (int bj = 0; bj < 2; ++bj) { const u32x4 bw = *(const u32x4*)(base + off + bj * HALF);
                    const f32x4 h0 = bf2x_lo(bw.x, bw.y) + acc[ai][bj][m][0] * scale, h1 = bf2x_lo(bw.z, bw.w) + acc[ai][bj][m][1] * scale;
                    *(u32x4*)(ob + off + bj * HALF) = pack8(h0, h1);
                    ss += (h0[0] * h0[0] + h0[1] * h0[1]) + (h0[2] * h0[2] + h0[3] * h0[3]) + (h1[0] * h1[0] + h1[1] * h1[1]) + (h1[2] * h1[2] + h1[3] * h1[3]); }
                ss += __shfl_xor(ss, 16); ss += __shfl_xor(ss, 32);
                if (fq == 0) part[(size_t)row * 16 + u.pn * 4 + wc] = ss;
                asm volatile("" ::: "memory"); }
    }
};

template <class Epi, class Sched, bool ALIGN_EPI = false, bool SP2 = false>
__device__ __forceinline__ void gemm_phase(PG8_LAS unsigned char* lds, const Gemm g, const Sched& S, const Epi& E) {
    const int tid = threadIdx.x, wid = __builtin_amdgcn_readfirstlane(tid >> 6), lane = tid & 63, wr = wid >> 2, wc = wid & 3, fr = lane & 15, fq = lane >> 4;
    const int K = g.K, nt = K / BK;
    unsigned voffA[2], voffB[2];
#pragma unroll
    for (int i = 0; i < 2; ++i) { int R, C; stage_rc(tid * 16 + i * 8192, R, C); const int Rb = Epi::PERM ? ((R & ~31) + perm32(R & 31)) : R;
        voffA[i] = (unsigned)(R * K + C) * 2u; voffB[i] = (unsigned)(Rb * K + C) * 2u; }
    const size_t kstep = (size_t)(BK * 2);
    const size_t hstep = (size_t)HALF * K * 2;
    const size_t tstep = 2 * hstep;
    const unsigned ldsw = (unsigned)wid * 1024u;
    const int aoff = lds_byte(wr * 64 + fr, fq * 8), boff = lds_byte(wc * 32 + fr, fq * 8);
#define PG8_SA(b, h) (((b) * 2 + (h)) * HTB)
#define PG8_SB(b, h) ((4 + (b) * 2 + (h)) * HTB)
#define PG8_STAGE(bufoff, gbase, voff) do { _Pragma("unroll") for (int _i = 0; _i < 2; ++_i) \
        __builtin_amdgcn_global_load_lds((const unsigned*)((const char*)(gbase) + (voff)[_i]), (PG8_LAS unsigned*)(lds + (bufoff) + ldsw + _i * 8192), 16, 0, 0); } while (0)
#define PG8_LDA(dst, b, h) do { _Pragma("unroll") for (int m = 0; m < 4; ++m) _Pragma("unroll") for (int k = 0; k < 2; ++k) dst[m][k] = *(const PG8_LAS bf16x8*)(lds + PG8_SA(b, h) + aoff + m * 2048 + k * 1024); } while (0)
#define PG8_LDB(dst, b, h) do { _Pragma("unroll") for (int n = 0; n < 2; ++n) _Pragma("unroll") for (int k = 0; k < 2; ++k) dst[n][k] = *(const PG8_LAS bf16x8*)(lds + PG8_SB(b, h) + boff + n * 2048 + k * 1024); } while (0)
#define PG8_MMA(ai, bj, At, Bt) do { __builtin_amdgcn_s_setprio(1); _Pragma("unroll") for (int m = 0; m < 4; ++m) _Pragma("unroll") for (int n = 0; n < 2; ++n) _Pragma("unroll") for (int k = 0; k < 2; ++k) \
        acc[ai][bj][m][n] = __builtin_amdgcn_mfma_f32_16x16x32_bf16(Bt[n][k], At[m][k], acc[ai][bj][m][n], 0, 0, 0); __builtin_amdgcn_s_setprio(0); } while (0)
#define PG8_WAIT_V(n) asm volatile("s_waitcnt vmcnt(" #n ")" ::: "memory")
#define PG8_WAIT_L(n) asm volatile("s_waitcnt lgkmcnt(" #n ")" ::: "memory")
#define PG8_BAR __builtin_amdgcn_s_barrier()
#define PG8_SCHED __builtin_amdgcn_sched_barrier(0)
    Unit cur, nxt; int ui = 0;
    if (!S.next(0, cur)) return;
    f32x4 acc[2][2][4][2];
#pragma unroll
    for (int a = 0; a < 2; ++a)
#pragma unroll
        for (int b = 0; b < 2; ++b)
#pragma unroll
            for (int m = 0; m < 4; ++m)
#pragma unroll
                for (int n = 0; n < 2; ++n) acc[a][b][m][n] = (f32x4){0.f, 0.f, 0.f, 0.f};
    bf16x8 At[4][2], B0[2][2], B1[2][2];
    const char* cA = (const char*)g.A + (size_t)cur.pm * tstep; const char* cB = (const char*)g.Bt + (size_t)cur.pn * tstep;
    S.a_ready(cur);
    if constexpr (SP2) {
        PG8_STAGE(PG8_SB(0, 0), cB, voffB); PG8_STAGE(PG8_SB(0, 1), cB + hstep, voffB); PG8_STAGE(PG8_SA(0, 0), cA, voffA); PG8_STAGE(PG8_SA(0, 1), cA + hstep, voffA);
        if (wr == 1) PG8_BAR;
        PG8_WAIT_V(2); PG8_BAR;
        PG8_STAGE(PG8_SB(1, 0), cB + kstep, voffB); PG8_STAGE(PG8_SA(1, 0), cA + kstep, voffA); PG8_STAGE(PG8_SB(1, 1), cB + hstep + kstep, voffB);
        PG8_WAIT_V(6); PG8_BAR;
    } else {
        PG8_STAGE(PG8_SB(0, 0), cB, voffB); PG8_STAGE(PG8_SA(0, 0), cA, voffA); PG8_STAGE(PG8_SB(0, 1), cB + hstep, voffB); PG8_STAGE(PG8_SA(0, 1), cA + hstep, voffA);
        if (wr == 1) PG8_BAR;
        PG8_WAIT_V(4); PG8_BAR;
        PG8_STAGE(PG8_SB(1, 0), cB + kstep, voffB); PG8_STAGE(PG8_SA(1, 0), cA + kstep, voffA); PG8_STAGE(PG8_SB(1, 1), cB + hstep + kstep, voffB);
        PG8_WAIT_V(6); PG8_BAR;
    }
    for (;;) {
        const bool has_next = S.next(ui + 1, nxt);
        const char* nA = has_next ? (const char*)g.A + (size_t)nxt.pm * tstep : cA; const char* nB = has_next ? (const char*)g.Bt + (size_t)nxt.pn * tstep : cB;
        for (int t = 0; t < nt; t += 2) {
            const bool last = (t == nt - 2);
            const char* a1 = cA + (size_t)(t + 1) * kstep;
            const char* a2 = last ? nA : cA + (size_t)(t + 2) * kstep; const char* b2 = last ? nB : cB + (size_t)(t + 2) * kstep;
            const char* a3 = a2 + kstep; const char* b3 = b2 + kstep;
            if (last && has_next) S.a_ready(nxt);
            if constexpr (SP2) {
            PG8_LDB(B0, 0, 0); PG8_LDB(B1, 0, 1); PG8_SCHED; PG8_LDA(At, 0, 0); PG8_STAGE(PG8_SA(1, 1), a1 + hstep, voffA);
            PG8_WAIT_V(8); PG8_WAIT_L(0); PG8_BAR; PG8_MMA(0, 0, At, B0); PG8_MMA(0, 1, At, B1); PG8_BAR; PG8_SCHED;
            PG8_LDA(At, 0, 1); PG8_STAGE(PG8_SB(0, 0), b2, voffB); PG8_STAGE(PG8_SB(0, 1), b2 + hstep, voffB); PG8_STAGE(PG8_SA(0, 0), a2, voffA);
            PG8_WAIT_V(8); PG8_WAIT_L(0); PG8_BAR; PG8_MMA(1, 0, At, B0); PG8_MMA(1, 1, At, B1); PG8_BAR; PG8_SCHED;
            PG8_LDB(B0, 1, 0); PG8_LDB(B1, 1, 1); PG8_SCHED; PG8_LDA(At, 1, 0); PG8_STAGE(PG8_SA(0, 1), a2 + hstep, voffA);
            PG8_WAIT_V(8); PG8_WAIT_L(0); PG8_BAR; PG8_MMA(0, 0, At, B0); PG8_MMA(0, 1, At, B1); PG8_BAR; PG8_SCHED;
            PG8_LDA(At, 1, 1); PG8_STAGE(PG8_SB(1, 0), b3, voffB); PG8_STAGE(PG8_SB(1, 1), b3 + hstep, voffB); PG8_STAGE(PG8_SA(1, 0), a3, voffA);
            PG8_WAIT_V(8); PG8_WAIT_L(0); PG8_BAR; PG8_MMA(1, 0, At, B0); PG8_MMA(1, 1, At, B1); PG8_BAR; PG8_SCHED;
            } else {
            PG8_LDB(B0, 0, 0); PG8_SCHED; PG8_LDA(At, 0, 0); PG8_STAGE(PG8_SA(1, 1), a1 + hstep, voffA);
            PG8_WAIT_L(8); PG8_BAR; PG8_WAIT_L(0); PG8_MMA(0, 0, At, B0); PG8_BAR; PG8_SCHED;
            PG8_LDB(B1, 0, 1); PG8_STAGE(PG8_SB(0, 0), b2, voffB);
            PG8_BAR; PG8_WAIT_L(0); PG8_MMA(0, 1, At, B1); PG8_BAR;
            PG8_LDA(At, 0, 1); PG8_STAGE(PG8_SA(0, 0), a2, voffA);
            PG8_BAR; PG8_WAIT_L(0); PG8_MMA(1, 0, At, B0); PG8_BAR; PG8_SCHED;
            PG8_STAGE(PG8_SB(0, 1), b2 + hstep, voffB);
            PG8_WAIT_V(6); PG8_BAR; PG8_MMA(1, 1, At, B1); PG8_BAR;
            PG8_LDB(B0, 1, 0); PG8_SCHED; PG8_LDA(At, 1, 0); PG8_STAGE(PG8_SA(0, 1), a2 + hstep, voffA);
            PG8_WAIT_L(8); PG8_BAR; PG8_WAIT_L(0); PG8_MMA(0, 0, At, B0); PG8_BAR; PG8_SCHED;
            PG8_LDB(B1, 1, 1); PG8_STAGE(PG8_SB(1, 0), b3, voffB);
            PG8_BAR; PG8_WAIT_L(0); PG8_MMA(0, 1, At, B1); PG8_BAR;
            PG8_LDA(At, 1, 1); PG8_STAGE(PG8_SA(1, 0), a3, voffA);
            PG8_BAR; PG8_WAIT_L(0); PG8_MMA(1, 0, At, B0); PG8_BAR; PG8_SCHED;
            PG8_STAGE(PG8_SB(1, 1), b3 + hstep, voffB);
            PG8_WAIT_V(6); PG8_BAR; PG8_MMA(1, 1, At, B1); PG8_BAR;
            }
        }
        if constexpr (ALIGN_EPI) { if (wr == 0) PG8_BAR; }
        if constexpr (!Epi::AFTER_DRAIN) { E(acc, cur, wr, wc, fr, fq); S.done(cur); }
        if (!has_next) break;
#pragma unroll
        for (int a = 0; a < 2; ++a)
#pragma unroll
            for (int b = 0; b < 2; ++b)
#pragma unroll
                for (int m = 0; m < 4; ++m)
#pragma unroll
                    for (int n = 0; n < 2; ++n) acc[a][b][m][n] = (f32x4){0.f, 0.f, 0.f, 0.f};
        cur = nxt; cA = nA; cB = nB; ++ui;
        if constexpr (ALIGN_EPI) { if (wr == 1) PG8_BAR; }
    }
    PG8_WAIT_V(0);
    if constexpr (!ALIGN_EPI) { if (wr == 0) PG8_BAR; }
    PG8_BAR;
    if constexpr (Epi::AFTER_DRAIN) { E.fused(acc, cur, wr, wc, fr, fq, lds, wid, lane); S.done(cur); }
#undef PG8_SA
#undef PG8_SB
#undef PG8_STAGE
#undef PG8_LDA
#undef PG8_LDB
#undef PG8_MMA
#undef PG8_WAIT_V
#undef PG8_WAIT_L
#undef PG8_BAR
#undef PG8_SCHED
}
}

constexpr int NWAVES = 8;
constexpr int BATCH = 8, SEQ = 2048, DM = 1024, FF = 2816, M = BATCH * SEQ;
constexpr int AIN = 2304, RIN = 3584;
constexpr float SB_EXIT = -105.0f;

constexpr size_t MiB = 1u << 20;
constexpr size_t WS_CTL = 0, CTL_ZERO_BYTES = 1 * MiB;
constexpr size_t WS_WFIN = 2 * MiB;
constexpr size_t WS_WFOUT = 46 * MiB;
constexpr size_t WS_WAIN = 68 * MiB, WS_WAOUT = 73 * MiB, WS_WRIN = 75 * MiB, WS_WROUT = 82 * MiB;
constexpr size_t WS_PART = 84 * MiB;
constexpr size_t WS_DEC = 85 * MiB;
constexpr size_t WS_HB = 86 * MiB;
constexpr size_t WS_SB = WS_WFIN;
constexpr size_t WS_OB = 118 * MiB;
constexpr size_t WS_ACT = 150 * MiB;
constexpr size_t WS_ST = 262 * MiB;
constexpr size_t WS_END = 326 * MiB;
constexpr int CW_BAR = 4096;

constexpr int RING_OFF = 0, RING_BYTES = 131072;
constexpr int LDSCTL_OFF = RING_BYTES, MISC_OFF = LDSCTL_OFF + 320;
constexpr int LDS_BYTES = 147456;

#define GAS __attribute__((address_space(1)))
#define LAS __attribute__((address_space(3)))
typedef unsigned short bf16;
typedef unsigned v4u __attribute__((ext_vector_type(4)));
typedef float f32x4 __attribute__((ext_vector_type(4)));
typedef short bf16x8 __attribute__((ext_vector_type(8)));
typedef GAS unsigned gu32;
typedef GAS unsigned long long gu64;
#define RLX_AGENT __ATOMIC_RELAXED, __HIP_MEMORY_SCOPE_AGENT
#define LDS_WAIT() asm volatile("s_waitcnt lgkmcnt(0)" ::: "memory")
#define VM_WAIT() asm volatile("s_waitcnt vmcnt(0)" ::: "memory")
__device__ __forceinline__ unsigned long long rt() { return __builtin_amdgcn_s_memrealtime(); }
__device__ __forceinline__ unsigned f2bf(float f) { unsigned u = __builtin_bit_cast(unsigned, f); return (u + 0x7fffu + ((u >> 16) & 1u)) >> 16; }
__device__ __forceinline__ unsigned pk2(float lo, float hi) { return f2bf(lo) | (f2bf(hi) << 16); }

#define XB_TMO      128
#define XB_XCNT(j)  (256  + 64 * (j))
#define XB_XSUB(j)  (1280 + 64 * (j))
#define XB_XGEN(j)  (2304 + 64 * (j))
#define XB_TOP      3328
#define XB_TOPGEN   3392
#define XCD_BAR_WORDS 3456
#define XB_SPIN_CAP (1u << 18)

__device__ __forceinline__ unsigned xb_ld(unsigned* p)              { return __hip_atomic_load(p, __ATOMIC_RELAXED, __HIP_MEMORY_SCOPE_AGENT); }
__device__ __forceinline__ unsigned xb_add(unsigned* p, unsigned v) { return __hip_atomic_fetch_add(p, v, __ATOMIC_RELAXED, __HIP_MEMORY_SCOPE_AGENT); }
__device__ __forceinline__ unsigned xb_xcc_id() { return (unsigned)__builtin_amdgcn_s_getreg((3 << 11) | 20) & 0xFu; }
#define XB_SPIN(cond, bar) do { unsigned _sp = 0; while (cond) { __builtin_amdgcn_s_sleep(1); \
    if ((++_sp & 255u) == 0u) { if (xb_ld(&(bar)[XB_TMO])) break; if (_sp > XB_SPIN_CAP) { atomicAdd(&(bar)[XB_TMO], 1u); break; } } } } while (0)

struct XcdBarrier {
    unsigned* bar; unsigned x;
    volatile LAS unsigned* st;
};

__device__ __forceinline__ XcdBarrier xcd_barrier_post(unsigned* bar, volatile LAS unsigned* st) {
    XcdBarrier b; b.bar = bar; b.x = xb_xcc_id(); b.st = st;
    if (threadIdx.x == 0) (void)xb_add(&bar[XB_XCNT(b.x)], 1u);
    return b;
}
__device__ __forceinline__ void xcd_barrier_complete(unsigned* bar, unsigned x, unsigned& nloc, unsigned& nx) {
    const unsigned G = gridDim.x * gridDim.y * gridDim.z;
    unsigned sum, cnt, mine, sp = 0u;
    for (;;) {
        sum = 0u; cnt = 0u; mine = 0u;
#pragma unroll
        for (unsigned j = 0; j < 16; ++j) { const unsigned c = xb_ld(&bar[XB_XCNT(j)]); sum += c; cnt += (c > 0u) ? 1u : 0u; mine = (j == x) ? c : mine; }
        if (sum == G) break;
        __builtin_amdgcn_s_sleep(1);
        if ((++sp & 255u) == 0u) { if (xb_ld(&bar[XB_TMO])) break; if (sp > XB_SPIN_CAP) { atomicAdd(&bar[XB_TMO], 1u); break; } }
    }
    nloc = mine > 0u ? mine : 1u; nx = cnt > 0u ? cnt : 1u;
}

__device__ __forceinline__ void xcd_barrier(const XcdBarrier& b) {
    asm volatile("s_waitcnt vmcnt(0)" ::: "memory");
    __syncthreads();
    if (threadIdx.x == 0) {
        unsigned* bar = b.bar;
        __builtin_amdgcn_s_waitcnt(0);
        unsigned nloc = b.st[0], nx = b.st[1];
        if (nloc == 0u) { xcd_barrier_complete(bar, b.x, nloc, nx); b.st[0] = nloc; b.st[1] = nx; }
        const unsigned old = xb_add(&bar[XB_XSUB(b.x)], 1u);
        const unsigned gen = old / nloc;
        if (old + 1u == (gen + 1u) * nloc) {
            __builtin_amdgcn_fence(__ATOMIC_RELEASE, "agent");
            asm volatile("s_waitcnt vmcnt(0)" ::: "memory");
            const unsigned og = xb_add(&bar[XB_TOP], 1u);
            const unsigned tg = og / nx;
            if (og + 1u == (tg + 1u) * nx) xb_add(&bar[XB_TOPGEN], 1u);
            else XB_SPIN(xb_ld(&bar[XB_TOPGEN]) == tg, bar);
            __builtin_amdgcn_fence(__ATOMIC_ACQUIRE, "agent");
            xb_add(&bar[XB_XGEN(b.x)], 1u);
            asm volatile("s_waitcnt vmcnt(0)" ::: "memory");
        } else {
            XB_SPIN(xb_ld(&bar[XB_XGEN(b.x)]) == gen, bar);
            __builtin_amdgcn_fence(__ATOMIC_ACQUIRE, "agent");
            asm volatile("s_waitcnt vmcnt(0)" ::: "memory");
        }
    }
    __syncthreads();
}


typedef float f32x16 __attribute__((ext_vector_type(16)));
typedef unsigned u32x2v __attribute__((ext_vector_type(2)));
__device__ __forceinline__ float bf2f(unsigned short v) { return __uint_as_float((unsigned)v << 16); }
__device__ __forceinline__ int crow(int r, int hi) { return (r & 3) + 8 * (r >> 2) + 4 * hi; }
__device__ __forceinline__ int swap23(int k) { return (k & ~12) | ((k & 4) << 1) | ((k & 8) >> 1); }
#define MFMA32(a, b, c) __builtin_amdgcn_mfma_f32_32x32x16_bf16((a), (b), (c), 0, 0, 0)
__device__ __forceinline__ bf16x8 packf8(float a0, float a1, float a2, float a3, float a4, float a5, float a6, float a7) {
    v4u w; w.x = pg8::cvt_pk_bf16(a0, a1); w.y = pg8::cvt_pk_bf16(a2, a3); w.z = pg8::cvt_pk_bf16(a4, a5); w.w = pg8::cvt_pk_bf16(a6, a7); return __builtin_bit_cast(bf16x8, w); }
__device__ __forceinline__ float wave_sum(float v) {
#pragma unroll
    for (int o = 1; o < 64; o <<= 1) v += __shfl_xor(v, o);
    return v;
}

__device__ __forceinline__ void p0_item(const float* W, int K, int N, bf16* WT, const float* gain, bool swg, LAS float* scr, int item, int lane) {
    const int nblk = N / 32, kb = item / nblk, nb = item % nblk, k0 = 64 * kb, n0 = 32 * nb;
    int sn0 = n0; if (swg) { const int pn = n0 >> 8, bj = (n0 >> 7) & 1, x0 = n0 & 127; sn0 = bj * FF + pn * 128 + x0; }
    const float gl = gain ? gain[k0 + lane] : 1.0f;
    float wv[32];
#pragma unroll
    for (int i = 0; i < 32; ++i) wv[i] = W[(size_t)(k0 + 2 * i + (lane >> 5)) * N + sn0 + (lane & 31)];
#pragma unroll
    for (int i = 0; i < 32; ++i) { const int kk = 2 * i + (lane >> 5); scr[kk * 33 + (lane & 31)] = wv[i] * __shfl(gl, kk); }
    LDS_WAIT(); asm volatile("" ::: "memory");
    const int c = lane & 7;
#pragma unroll
    for (int j = 0; j < 4; ++j) { const int n = (lane >> 3) + 8 * j; const LAS float* s = scr + (8 * c) * 33 + n;
        v4u o; o.x = pk2(s[0 * 33], s[1 * 33]); o.y = pk2(s[2 * 33], s[3 * 33]); o.z = pk2(s[4 * 33], s[5 * 33]); o.w = pk2(s[6 * 33], s[7 * 33]);
        *(GAS v4u*)(WT + (size_t)(n0 + n) * K + k0 + 8 * c) = o; }
    LDS_WAIT(); asm volatile("" ::: "memory");
}

struct Ptrs {
    const float *x, *norm_g, *ffn_w_in, *ffn_w_out, *attn_w_in, *attn_sinks, *attn_w_out, *rec_w_in, *lb_logits, *hgrn_norm_g, *conv_w, *rec_w_out, *final_g;
    float* out; unsigned char* ws;
};

__device__ __forceinline__ void p0_prologue(const Ptrs& P, LAS unsigned char* lds, int wave, int lane) {
    LAS float* scr = (LAS float*)(lds + RING_OFF + wave * 16384);
    const int gw = blockIdx.x * NWAVES + wave, NGW = gridDim.x * NWAVES;
    constexpr int I_FIN = (DM / 64) * (2 * FF / 32), I_FOUT = (FF / 64) * (DM / 32), I_AIN = (DM / 64) * (AIN / 32), I_O = (DM / 64) * (DM / 32), I_RIN = (DM / 64) * (RIN / 32);
    constexpr int NITEMS = 4 * I_FIN + 4 * I_FOUT + I_AIN + I_O + I_RIN + I_O;
    unsigned char* ws = P.ws;
    for (int it = gw; it < NITEMS; it += NGW) {
        int r = it;
        if (r < 4 * I_FIN) { const int w = r / I_FIN, l = w >> 1, j = w & 1; p0_item(P.ffn_w_in + (size_t)w * DM * 2 * FF, DM, 2 * FF, (bf16*)(ws + WS_WFIN) + (size_t)w * 2 * FF * DM, P.norm_g + (l * 3 + (j ? 2 : 0)) * DM, true, scr, r % I_FIN, lane); continue; } r -= 4 * I_FIN;
        if (r < 4 * I_FOUT) { const int w = r / I_FOUT; p0_item(P.ffn_w_out + (size_t)w * FF * DM, FF, DM, (bf16*)(ws + WS_WFOUT) + (size_t)w * DM * FF, nullptr, false, scr, r % I_FOUT, lane); continue; } r -= 4 * I_FOUT;
        if (r < I_AIN) { p0_item(P.attn_w_in, DM, AIN, (bf16*)(ws + WS_WAIN), P.norm_g + (0 * 3 + 1) * DM, false, scr, r, lane); continue; } r -= I_AIN;
        if (r < I_O) { p0_item(P.attn_w_out, DM, DM, (bf16*)(ws + WS_WAOUT), nullptr, false, scr, r, lane); continue; } r -= I_O;
        if (r < I_RIN) { p0_item(P.rec_w_in, DM, RIN, (bf16*)(ws + WS_WRIN), P.norm_g + (1 * 3 + 1) * DM, false, scr, r, lane); continue; } r -= I_RIN;
        p0_item(P.rec_w_out, DM, DM, (bf16*)(ws + WS_WROUT), nullptr, false, scr, r, lane);
    }
    bf16* hb = (bf16*)(ws + WS_HB); float* part = (float*)(ws + WS_PART);
    for (int m = gw; m < M; m += NGW) {
        const GAS f32x4* xr = (const GAS f32x4*)(P.x + (size_t)m * DM) + lane;
        f32x4 v[4]; float s = 0.f;
#pragma unroll
        for (int j = 0; j < 4; ++j) { v[j] = xr[64 * j]; s += (v[j].x * v[j].x + v[j].y * v[j].y) + (v[j].z * v[j].z + v[j].w * v[j].w); }
        s = wave_sum(s);
        GAS unsigned long long* o8 = (GAS unsigned long long*)(hb + (size_t)m * DM) + lane;
#pragma unroll
        for (int j = 0; j < 4; ++j) o8[64 * j] = (unsigned long long)pk2(v[j].x, v[j].y) | ((unsigned long long)pk2(v[j].z, v[j].w) << 32);
        if (lane < 16) part[(size_t)m * 16 + lane] = lane == 0 ? s : 0.f;
    }
}

__device__ __forceinline__ void final_norm(const Ptrs& P, int wave, int lane) {
    const int gw = blockIdx.x * NWAVES + wave, NGW = gridDim.x * NWAVES;
    const bf16* hb = (const bf16*)(P.ws + WS_HB);
    f32x4 g[4];
#pragma unroll
    for (int j = 0; j < 4; ++j) g[j] = ((const f32x4*)P.final_g)[2 * lane + (j & 1) + 128 * (j >> 1)];
    for (int m = gw; m < M; m += NGW) {
        const v4u* hr = (const v4u*)(hb + (size_t)m * DM) + lane;
        f32x4 v[4]; float s = 0.f;
#pragma unroll
        for (int jj = 0; jj < 2; ++jj) { const v4u w = hr[64 * jj]; v[2 * jj] = pg8::bf2x_lo(w.x, w.y); v[2 * jj + 1] = pg8::bf2x_lo(w.z, w.w); }
#pragma unroll
        for (int j = 0; j < 4; ++j) s += (v[j].x * v[j].x + v[j].y * v[j].y) + (v[j].z * v[j].z + v[j].w * v[j].w);
        const float r = 1.0f / sqrtf(wave_sum(s) * (1.0f / DM) + pg8::RMS_EPS);
        GAS f32x4* orow = (GAS f32x4*)(P.out + (size_t)m * DM);
#pragma unroll
        for (int j = 0; j < 4; ++j) orow[2 * lane + (j & 1) + 128 * (j >> 1)] = v[j] * r * g[j];
    }
}

constexpr int VSTR = 80;
constexpr int VT_BYTES = 64 * VSTR;
constexpr int OTSTR = 144;
__device__ __forceinline__ void load_v(const bf16* vsrc, int pitch, int lane, bf16x8 (&v)[4]) {
#pragma unroll
    for (int i = 0; i < 4; ++i) v[i] = *(const bf16x8*)(vsrc + (size_t)(i * 8 + (lane >> 3)) * pitch + 8 * (lane & 7));
}
__device__ __forceinline__ void stage_vt(LAS unsigned char* vt, int lane, const bf16x8 (&v)[4]) {
#pragma unroll
    for (int i = 0; i < 4; ++i) { const int kk = i * 8 + (lane >> 3), p = (kk & 16) | swap23(kk & 15), c = lane & 7;
#pragma unroll
        for (int j = 0; j < 8; ++j) *(LAS short*)(vt + (8 * c + j) * VSTR + 2 * p) = v[i][j]; }
}
__device__ __forceinline__ bf16x8 read_vt(const LAS unsigned char* vt, int d, int s2, int h) { return *(const LAS bf16x8*)(vt + d * VSTR + 32 * s2 + 16 * h); }
__device__ __forceinline__ void load_k(const bf16* kp, bf16x8 (&k)[4]) {
#pragma unroll
    for (int st = 0; st < 4; ++st) k[st] = *(const bf16x8*)(kp + 16 * st);
}
__device__ __forceinline__ void store_o(LAS unsigned char* ot, bf16* op  , const f32x16& O0, const f32x16& O1, int lane) {
    const int c = lane & 31, hi = lane >> 5;
#pragma unroll
    for (int r = 0; r < 16; ++r) { LAS unsigned char* p = ot + crow(r, hi) * OTSTR + 2 * c; *(LAS unsigned short*)p = (unsigned short)f2bf(O0[r]); *(LAS unsigned short*)(p + 64) = (unsigned short)f2bf(O1[r]); }
#pragma unroll
    for (int i = 0; i < 4; ++i) { const int row = i * 8 + (lane >> 3), ch = lane & 7; *(bf16x8*)(op + (size_t)row * DM + 8 * ch) = *(const LAS bf16x8*)(ot + row * OTSTR + 16 * ch); }
}

__device__ __forceinline__ void swa_unit(const bf16* qkv, bf16* obuf, const float* sinks, int b, int hq, int qb, LAS unsigned char* vt, int lane) {
    const int c = lane & 31, hi = lane >> 5, kvh = hq >> 2;
    const size_t rowbase = (size_t)b * SEQ;
    const bf16* qp = qkv + (rowbase + qb * 32 + c) * AIN + hq * 64 + 8 * hi;
    bf16x8 qf[4]; load_k(qp, qf);
    bf16x8 kf[5][4];
#pragma unroll
    for (int i = 0; i < 5; ++i) { const int kb = qb - 4 + i; if (kb >= 0) load_k(qkv + (rowbase + kb * 32 + c) * AIN + 512 + kvh * 64 + 8 * hi, kf[i]); }
    const bf16* vbase = qkv + rowbase * AIN + 640 + kvh * 64;
    const int i0 = qb >= 4 ? 0 : 4 - qb;
    bf16x8 vcur[4], vnext[4];
    load_v(vbase + (size_t)(qb - 4 + i0) * 32 * AIN, AIN, lane, vcur);
    const float slope = exp2f(-(float)(hq + 1)), sink = sinks[hq];
    f32x16 X[5]; float mx = -INFINITY;
#pragma unroll
    for (int i = 0; i < 5; ++i) { const int kb = qb - 4 + i;
        f32x16 a;
#pragma unroll
        for (int r = 0; r < 16; ++r) a[r] = 0.f;
        if (kb >= 0) {
#pragma unroll
            for (int st = 0; st < 4; ++st) a = MFMA32(kf[i][st], qf[st], a);
#pragma unroll
            for (int r = 0; r < 16; ++r) { const int dist = (qb * 32 + c) - (kb * 32 + crow(r, hi)); const bool valid = dist >= 0 && dist < 128;
                const float s = valid ? a[r] * 0.125f - slope * (float)dist : -INFINITY; a[r] = s; mx = fmaxf(mx, s); }
        } else {
#pragma unroll
            for (int r = 0; r < 16; ++r) a[r] = -INFINITY;
        }
        X[i] = a; }
    mx = fmaxf(mx, __shfl_xor(mx, 32)); mx = fmaxf(mx, sink);
    float sum = 0.f;
#pragma unroll
    for (int i = 0; i < 5; ++i)
#pragma unroll
        for (int r = 0; r < 16; ++r) { const float p = __expf(X[i][r] - mx); X[i][r] = p; sum += p; }
    sum += __shfl_xor(sum, 32);
    const float inv = 1.0f / (sum + __expf(sink - mx));
    f32x16 O0, O1;
#pragma unroll
    for (int r = 0; r < 16; ++r) { O0[r] = 0.f; O1[r] = 0.f; }
#pragma unroll
    for (int i = 0; i < 5; ++i) { const int kb = qb - 4 + i;
        if (kb >= 0) {
            if (i < 4) load_v(vbase + (size_t)(kb + 1) * 32 * AIN, AIN, lane, vnext);
            stage_vt(vt, lane, vcur);
#pragma unroll
            for (int s2 = 0; s2 < 2; ++s2) {
                const bf16x8 pf = packf8(X[i][8 * s2 + 0] * inv, X[i][8 * s2 + 1] * inv, X[i][8 * s2 + 2] * inv, X[i][8 * s2 + 3] * inv, X[i][8 * s2 + 4] * inv, X[i][8 * s2 + 5] * inv, X[i][8 * s2 + 6] * inv, X[i][8 * s2 + 7] * inv);
                O0 = MFMA32(pf, read_vt(vt, c, s2, hi), O0); O1 = MFMA32(pf, read_vt(vt, c + 32, s2, hi), O1); }
            if (i < 4) {
#pragma unroll
                for (int k = 0; k < 4; ++k) vcur[k] = vnext[k]; }
        } }
    store_o(vt + VT_BYTES, obuf + (rowbase + qb * 32) * DM + hq * 64, O0, O1, lane);
}

__device__ __forceinline__ void sb_unit(const bf16* qkv, bf16* obuf, int b, int h, int qb, LAS unsigned char* vt, int lane) {
    const int c = lane & 31, hi = lane >> 5, t = qb * 32 + c;
    const size_t rowbase = (size_t)b * SEQ;
    bf16x8 qf[4]; load_k(qkv + (rowbase + t) * AIN + 768 + h * 64 + 8 * hi, qf);
    const bf16* kbase = qkv + (rowbase + c) * AIN + 1280 + h * 64 + 8 * hi;
    const bf16* vbase = qkv + rowbase * AIN + 1792 + h * 64;
    bf16x8 kf[4], vf[4], kn[4], vn[4];
    load_k(kbase + (size_t)qb * 32 * AIN, kf); load_v(vbase + (size_t)qb * 32 * AIN, AIN, lane, vf);
    float carry = 0.f;
    f32x16 O0, O1;
#pragma unroll
    for (int r = 0; r < 16; ++r) { O0[r] = 0.f; O1[r] = 0.f; }
    for (int kb = qb; kb >= 0; --kb) {
        { const int kbn = kb > 0 ? kb - 1 : 0; load_k(kbase + (size_t)kbn * 32 * AIN, kn); load_v(vbase + (size_t)kbn * 32 * AIN, AIN, lane, vn); }
        f32x16 a;
#pragma unroll
        for (int r = 0; r < 16; ++r) a[r] = 0.f;
#pragma unroll
        for (int st = 0; st < 4; ++st) a = MFMA32(kf[st], qf[st], a);
        float lk[16], lsg[16];
#pragma unroll
        for (int r = 0; r < 16; ++r) { const float z = a[r] * 0.125f; const bool causal = (kb * 32 + crow(r, hi)) < t;
            const float sp = fmaxf(z, 0.f) + __logf(1.0f + __expf(-fabsf(z)));
            lk[r] = causal ? -sp : 0.f; lsg[r] = z - sp; }
        float G[4], Gp[4];
#pragma unroll
        for (int g = 0; g < 4; ++g) { G[g] = (lk[4 * g] + lk[4 * g + 1]) + (lk[4 * g + 2] + lk[4 * g + 3]); Gp[g] = __shfl_xor(G[g], 32); }
        float tail = 0.f; f32x16 w;
#pragma unroll
        for (int g = 3; g >= 0; --g) { const float base = carry + tail + (hi == 0 ? Gp[g] : 0.f); float run = 0.f;
#pragma unroll
            for (int i = 3; i >= 0; --i) { const int r = 4 * g + i; const bool causal = (kb * 32 + crow(r, hi)) < t;
                w[r] = causal ? __expf(lsg[r] + base + run) : 0.f; run += lk[r]; }
            tail += G[g] + Gp[g]; }
        carry += tail;
        stage_vt(vt, lane, vf);
#pragma unroll
        for (int s2 = 0; s2 < 2; ++s2) {
            const bf16x8 pf = packf8(w[8 * s2 + 0], w[8 * s2 + 1], w[8 * s2 + 2], w[8 * s2 + 3], w[8 * s2 + 4], w[8 * s2 + 5], w[8 * s2 + 6], w[8 * s2 + 7]);
            O0 = MFMA32(pf, read_vt(vt, c, s2, hi), O0); O1 = MFMA32(pf, read_vt(vt, c + 32, s2, hi), O1); }
        if (__all(carry < SB_EXIT)) break;
#pragma unroll
        for (int k = 0; k < 4; ++k) { kf[k] = kn[k]; vf[k] = vn[k]; }
    }
    store_o(vt + VT_BYTES, obuf + (rowbase + qb * 32) * DM + 512 + h * 64, O0, O1, lane);
}

__device__ __forceinline__ void attn_phase(const Ptrs& P, LAS unsigned char* lds, int wave, int lane) {
    const bf16* qkv = (const bf16*)(P.ws + WS_ACT); bf16* obuf = (bf16*)(P.ws + WS_OB);
    LAS unsigned char* vt = lds + RING_OFF + wave * 10240;
    const int gw = blockIdx.x * NWAVES + wave, NGW = gridDim.x * NWAVES;
    constexpr int NU = BATCH * 8 * (SEQ / 32);
    for (int u = gw; u < 2 * NU; u += NGW) {
        if (u < NU) { const int qb = (SEQ / 32 - 1) - (u >> 6), bh = u & 63; sb_unit(qkv, obuf, bh >> 3, bh & 7, qb, vt, lane); }
        else { const int v = u - NU, qb = v >> 6, bh = v & 63; swa_unit(qkv, obuf, P.attn_sinks, bh >> 3, bh & 7, qb, vt, lane); }
    }
}

constexpr int KSTR = 144;
constexpr int QSTR = 272;
constexpr int OSTR = 132;
constexpr int L_TOT = 0, L_GL = 2048, L_KS = L_GL + 64 * OSTR * 4, L_VT = L_KS + 128 * KSTR, L_RZ = L_VT + 128 * KSTR, L_RV = L_RZ + 64 * QSTR, L_A_END = L_RV + 64 * QSTR;
constexpr int L_QI = L_KS, L_QX = L_QI + 64 * QSTR, L_KX = L_QX + 64 * QSTR, L_VT2 = L_KX + 64 * QSTR, L_OF = L_GL, L_RS = L_VT2 + 128 * KSTR, L_C_END = L_RS + 256;
static_assert(L_A_END <= RING_BYTES && L_C_END <= RING_BYTES, "HGRN2 LDS map");

__device__ __forceinline__ float hgrn_lb(const float* logits, int col) {
    const float l0 = logits[col], l1 = logits[512 + col]; return 1.0f / (1.0f + __expf(l0 - l1));
}
__device__ __forceinline__ void tile_load(const bf16* src, int tid, bf16x8 (&r)[2]) {
#pragma unroll
    for (int i = 0; i < 2; ++i) { const int ci = tid + 512 * i; r[i] = *(const bf16x8*)(src + (size_t)(ci >> 4) * RIN + 8 * (ci & 15)); }
}
__device__ __forceinline__ void tile_to_lds(LAS unsigned char* dst, int tid, const bf16x8 (&r)[2]) {
#pragma unroll
    for (int i = 0; i < 2; ++i) { const int ci = tid + 512 * i; *(LAS bf16x8*)(dst + (ci >> 4) * QSTR + 16 * (ci & 15)) = r[i]; }
}
__device__ __forceinline__ float lds_bf(const LAS unsigned char* img, int t, int d) { return bf2f(*(const LAS unsigned short*)(img + t * QSTR + 2 * d)); }
__device__ __forceinline__ void hgrn_gates(const LAS unsigned char* rz, int d, int tq, float lbv, LAS float* tot, LAS float* GL) {
    float cum = 0.f;
#pragma unroll
    for (int j = 0; j < 16; ++j) { const float z = lds_bf(rz, tq * 16 + j, d);
        const float sg = 1.0f / (1.0f + __expf(-z)); cum += __logf(lbv + (1.0f - lbv) * sg); GL[(tq * 16 + j) * 128 + d] = cum; }
    tot[tq * 128 + d] = cum;
    __syncthreads();
}

__device__ __forceinline__ void rec_pass_a(const Ptrs& P, LAS unsigned char* lds, int wave, int lane) {
    const bf16* qkv = (const bf16*)(P.ws + WS_ACT); bf16* obuf = (bf16*)(P.ws + WS_OB);
    float* st = (float*)(P.ws + WS_ST); float* dec = (float*)(P.ws + WS_DEC);
    const int tid = threadIdx.x, d = tid & 127, tq = tid >> 7, c = lane & 31, hi = lane >> 5, G = gridDim.x;
    LAS float* tot = (LAS float*)(lds + L_TOT); LAS float* GL = (LAS float*)(lds + L_GL);
    bf16x8 pz[2], pv[2];
    int u = blockIdx.x;
    if (u < 1024) { const bf16* src = qkv + ((size_t)(u >> 7) * SEQ + (u & 31) * 64) * RIN + ((u >> 5) & 3) * 128; tile_load(src + 512, tid, pz); tile_load(src + 1024, tid, pv); }
    for (; u < 1024; u += G) {
        const int hh = (u >> 5) & 3;
        tile_to_lds(lds + L_RZ, tid, pz); tile_to_lds(lds + L_RV, tid, pv);
        { const int un = u + G; if (un < 1024) { const bf16* src = qkv + ((size_t)(un >> 7) * SEQ + (un & 31) * 64) * RIN + ((un >> 5) & 3) * 128; tile_load(src + 512, tid, pz); tile_load(src + 1024, tid, pv); } }
        __syncthreads();
        const float lbv = hgrn_lb(P.lb_logits, hh * 128 + d);
        hgrn_gates(lds + L_RZ, d, tq, lbv, tot, GL);
        float off = 0.f;
#pragma unroll
        for (int q = 0; q < 3; ++q) off += (q < tq) ? tot[q * 128 + d] : 0.f;
        const float glast = tot[d] + tot[128 + d] + tot[256 + d] + tot[384 + d];
        if (tq == 0) dec[u * 128 + d] = __expf(glast);
#pragma unroll
        for (int grp = 0; grp < 2; ++grp) {
            float ks[8]; bf16x8 vv;
#pragma unroll
            for (int j = 0; j < 8; ++j) { const int t = tq * 16 + grp * 8 + j; const float z = lds_bf(lds + L_RZ, t, d), g = GL[t * 128 + d] + off;
                ks[j] = (1.0f - lbv) / (1.0f + __expf(z)) * __expf(glast - g); vv[j] = *(const LAS short*)(lds + L_RV + t * QSTR + 2 * d); }
            *(LAS bf16x8*)(lds + L_KS + d * KSTR + tq * 32 + grp * 16) = packf8(ks[0], ks[1], ks[2], ks[3], ks[4], ks[5], ks[6], ks[7]);
            *(LAS bf16x8*)(lds + L_VT + d * KSTR + tq * 32 + grp * 16) = vv;
        }
        __syncthreads();
        const int eb = wave >> 1;
#pragma unroll
        for (int dbi = 0; dbi < 2; ++dbi) { const int db = 2 * (wave & 1) + dbi;
            f32x16 acc;
#pragma unroll
            for (int r = 0; r < 16; ++r) acc[r] = 0.f;
#pragma unroll
            for (int s = 0; s < 4; ++s) acc = MFMA32(*(const LAS bf16x8*)(lds + L_VT + (eb * 32 + c) * KSTR + 32 * s + 16 * hi), *(const LAS bf16x8*)(lds + L_KS + (db * 32 + c) * KSTR + 32 * s + 16 * hi), acc);
            float* sp = st + ((size_t)u * 128 + eb * 32) * 128 + db * 32 + c;
#pragma unroll
            for (int r = 0; r < 16; ++r) sp[(size_t)crow(r, hi) * 128] = acc[r]; }
        __syncthreads();
    }
    const int gid = blockIdx.x * (NWAVES * 64) + tid, NT = gridDim.x * NWAVES * 64;
#pragma unroll 2
    for (int it = gid; it < M * 64; it += NT) {
        const int row = it >> 6, c8 = (it & 63) * 8, t = row & (SEQ - 1);
        const bf16* rp = qkv + (size_t)row * RIN; const bf16* rp1 = t >= 1 ? rp - RIN : rp; const bf16* rp2 = t >= 2 ? rp - 2 * RIN : rp;
        const float m1 = t >= 1 ? 1.f : 0.f, m2 = t >= 2 ? 1.f : 0.f;
        const bf16x8 gb = *(const bf16x8*)(rp + 2048 + c8), gc0 = *(const bf16x8*)(rp + 2560 + c8), u0 = *(const bf16x8*)(rp + 3072 + c8);
        const bf16x8 gc1 = *(const bf16x8*)(rp1 + 2560 + c8), u1 = *(const bf16x8*)(rp1 + 3072 + c8), gc2 = *(const bf16x8*)(rp2 + 2560 + c8), u2 = *(const bf16x8*)(rp2 + 3072 + c8);
        const f32x4 w0a = *(const f32x4*)(P.conv_w + c8), w0b = *(const f32x4*)(P.conv_w + c8 + 4), w1a = *(const f32x4*)(P.conv_w + 512 + c8), w1b = *(const f32x4*)(P.conv_w + 512 + c8 + 4), w2a = *(const f32x4*)(P.conv_w + 1024 + c8), w2b = *(const f32x4*)(P.conv_w + 1024 + c8 + 4);
        float o[8];
#pragma unroll
        for (int j = 0; j < 8; ++j) { const float w0 = j < 4 ? w0a[j & 3] : w0b[j & 3], w1 = j < 4 ? w1a[j & 3] : w1b[j & 3], w2 = j < 4 ? w2a[j & 3] : w2b[j & 3];
            const float x0 = bf2f((unsigned short)gc0[j]) * bf2f((unsigned short)u0[j]), x1 = m1 * bf2f((unsigned short)gc1[j]) * bf2f((unsigned short)u1[j]), x2 = m2 * bf2f((unsigned short)gc2[j]) * bf2f((unsigned short)u2[j]);
            o[j] = bf2f((unsigned short)gb[j]) * (w0 * x2 + w1 * x1 + w2 * x0); }
        *(bf16x8*)(obuf + (size_t)row * DM + 512 + c8) = packf8(o[0], o[1], o[2], o[3], o[4], o[5], o[6], o[7]);
    }
}

__device__ __forceinline__ void rec_pass_b(const Ptrs& P) {
    const float* st = (const float*)(P.ws + WS_ST); const float* dec = (const float*)(P.ws + WS_DEC); bf16* sb = (bf16*)(P.ws + WS_SB);
    const int gid = blockIdx.x * (NWAVES * 64) + threadIdx.x, NT = gridDim.x * NWAVES * 64;
    for (int x = gid; x < 32 * 4096; x += NT) {
        const int seq = x >> 12, ed = (x & 4095) * 4, d = ed & 127; f32x4 S = {0.f, 0.f, 0.f, 0.f};
#pragma unroll 1
        for (int half = 0; half < 2; ++half) {
            f32x4 kv[16], dc[16];
#pragma unroll
            for (int i = 0; i < 16; ++i) { const size_t u = (size_t)seq * 32 + half * 16 + i; kv[i] = *(const f32x4*)(st + u * 16384 + ed); dc[i] = *(const f32x4*)(dec + u * 128 + d); }
#pragma unroll
            for (int i = 0; i < 16; ++i) { const size_t u = (size_t)seq * 32 + half * 16 + i;
                u32x2v w; w.x = pg8::cvt_pk_bf16(S[0], S[1]); w.y = pg8::cvt_pk_bf16(S[2], S[3]); *(u32x2v*)(sb + u * 16384 + ed) = w;
                S = dc[i] * S + kv[i]; }
        }
    }
}

__device__ __forceinline__ void rec_pass_c(const Ptrs& P, LAS unsigned char* lds, int wave, int lane) {
    const bf16* qkv = (const bf16*)(P.ws + WS_ACT); bf16* obuf = (bf16*)(P.ws + WS_OB); const bf16* sb = (const bf16*)(P.ws + WS_SB);
    const int tid = threadIdx.x, d = tid & 127, tq = tid >> 7, c = lane & 31, hi = lane >> 5, G = gridDim.x;
    const int tb = wave & 1, eb = wave >> 1;
    LAS float* tot = (LAS float*)(lds + L_TOT); LAS float* GL = (LAS float*)(lds + L_GL); LAS float* OF = (LAS float*)(lds + L_OF); LAS float* RS = (LAS float*)(lds + L_RS);
    bf16x8 pq[2], pz[2], pv[2];
    int u = blockIdx.x;
    if (u < 1024) { const bf16* src = qkv + ((size_t)(u >> 7) * SEQ + (u & 31) * 64) * RIN + ((u >> 5) & 3) * 128; tile_load(src, tid, pq); tile_load(src + 512, tid, pz); tile_load(src + 1024, tid, pv); }
    for (; u < 1024; u += G) {
        const int b = u >> 7, hh = (u >> 5) & 3, ch = u & 31; const size_t row0 = (size_t)b * SEQ + ch * 64;
        tile_to_lds(lds + L_QI, tid, pq); tile_to_lds(lds + L_KX, tid, pz); tile_to_lds(lds + L_QX, tid, pv);
        bf16x8 sf[8], pg[2];
        { const bf16* sp = sb + ((size_t)u * 128 + eb * 32 + c) * 128 + 8 * hi;
#pragma unroll
            for (int s = 0; s < 8; ++s) sf[s] = *(const bf16x8*)(sp + 16 * s); }
        tile_load(qkv + row0 * RIN + 1536 + hh * 128, tid, pg);
        { const int un = u + G; if (un < 1024) { const bf16* src = qkv + ((size_t)(un >> 7) * SEQ + (un & 31) * 64) * RIN + ((un >> 5) & 3) * 128; tile_load(src, tid, pq); tile_load(src + 512, tid, pz); tile_load(src + 1024, tid, pv); } }
        __syncthreads();
        const float lbv = hgrn_lb(P.lb_logits, hh * 128 + d);
        hgrn_gates(lds + L_KX, d, tq, lbv, tot, GL);
        float off = 0.f;
#pragma unroll
        for (int q = 0; q < 3; ++q) off += (q < tq) ? tot[q * 128 + d] : 0.f;
        const float gref = tot[d] + tot[128 + d];
#pragma unroll
        for (int grp = 0; grp < 2; ++grp) { bf16x8 vv;
#pragma unroll
            for (int k = 0; k < 8; ++k) { const int j = (k & 3) + 8 * (k >> 2) + 4 * grp; vv[k] = *(const LAS short*)(lds + L_QX + (tq * 16 + j) * QSTR + 2 * d); }
            *(LAS bf16x8*)(lds + L_VT2 + d * KSTR + tq * 32 + grp * 16) = vv; }
#pragma unroll 4
        for (int j = 0; j < 16; ++j) { const int t = tq * 16 + j;
            const float qv = lds_bf(lds + L_QI, t, d), z = lds_bf(lds + L_KX, t, d), g = GL[t * 128 + d] + off, sq = pg8::silu_f(qv);
            const float kx = (1.0f - lbv) / (1.0f + __expf(z)) * __expf(fminf(gref - g, 80.f));
            *(LAS unsigned short*)(lds + L_QI + t * QSTR + 2 * d) = (unsigned short)f2bf(sq * __expf(g));
            *(LAS unsigned short*)(lds + L_QX + t * QSTR + 2 * d) = (unsigned short)f2bf(sq * __expf(fminf(g - gref, 80.f)));
            *(LAS unsigned short*)(lds + L_KX + t * QSTR + 2 * d) = (unsigned short)f2bf(kx); }
        __syncthreads();
        f32x16 acc;
#pragma unroll
        for (int r = 0; r < 16; ++r) acc[r] = 0.f;
#pragma unroll
        for (int s = 0; s < 8; ++s) acc = MFMA32(*(const LAS bf16x8*)(lds + L_QI + (tb * 32 + c) * QSTR + 32 * s + 16 * hi), sf[s], acc);
        for (int sbk = 0; sbk <= tb; ++sbk) {
            f32x16 X;
#pragma unroll
            for (int r = 0; r < 16; ++r) X[r] = 0.f;
#pragma unroll
            for (int s = 0; s < 8; ++s) X = MFMA32(*(const LAS bf16x8*)(lds + L_KX + (sbk * 32 + c) * QSTR + 32 * s + 16 * hi), *(const LAS bf16x8*)(lds + L_QX + (tb * 32 + c) * QSTR + 32 * s + 16 * hi), X);
#pragma unroll
            for (int r = 0; r < 16; ++r) X[r] = (sbk * 32 + crow(r, hi) <= tb * 32 + c) ? X[r] : 0.f;
#pragma unroll
            for (int s2 = 0; s2 < 2; ++s2) {
                const bf16x8 pf = packf8(X[8 * s2 + 0], X[8 * s2 + 1], X[8 * s2 + 2], X[8 * s2 + 3], X[8 * s2 + 4], X[8 * s2 + 5], X[8 * s2 + 6], X[8 * s2 + 7]);
                acc = MFMA32(pf, *(const LAS bf16x8*)(lds + L_VT2 + (eb * 32 + c) * KSTR + sbk * 64 + 32 * s2 + 16 * hi), acc); }
        }
#pragma unroll
        for (int r = 0; r < 16; ++r) OF[(tb * 32 + crow(r, hi)) * OSTR + eb * 32 + c] = acc[r];
        __syncthreads();
        { const int t = tid >> 3, pt = tid & 7; float ss = 0.f;
#pragma unroll
            for (int k = 0; k < 16; ++k) { const float v = OF[t * OSTR + pt * 16 + k]; ss += v * v; }
            ss += __shfl_xor(ss, 1); ss += __shfl_xor(ss, 2); ss += __shfl_xor(ss, 4);
            if (pt == 0) RS[t] = 1.0f / sqrtf(ss * (1.0f / 128.0f) + pg8::RMS_EPS); }
        __syncthreads();
#pragma unroll
        for (int i = 0; i < 2; ++i) { const int ci = tid + 512 * i, t = ci >> 4, e8 = 8 * (ci & 15);
            const f32x4 o0 = *(const LAS f32x4*)(OF + t * OSTR + e8), o1 = *(const LAS f32x4*)(OF + t * OSTR + e8 + 4);
            const f32x4 g0 = *(const f32x4*)(P.hgrn_norm_g + e8), g1 = *(const f32x4*)(P.hgrn_norm_g + e8 + 4); const float rs = RS[t];
            float o[8];
#pragma unroll
            for (int k = 0; k < 8; ++k) { const float gate = bf2f((unsigned short)pg[i][k]); o[k] = (k < 4 ? o0[k & 3] * g0[k & 3] : o1[k & 3] * g1[k & 3]) * rs * pg8::silu_f(gate); }
            *(bf16x8*)(obuf + (row0 + t) * DM + hh * 128 + e8) = packf8(o[0], o[1], o[2], o[3], o[4], o[5], o[6], o[7]); }
        __syncthreads();
    }
}

constexpr int N_PHASES = 18;
struct Args { Ptrs p; int ph_lo, ph_hi; };
__global__ void __launch_bounds__(NWAVES * 64, 2) trunk_fwd(Args args) {
    extern __shared__ __attribute__((aligned(16))) unsigned char lds_raw[];
    LAS unsigned char* lds = (LAS unsigned char*)lds_raw;
    volatile LAS unsigned* MISC = (volatile LAS unsigned*)(lds + MISC_OFF);
    const int tid = threadIdx.x, lane = tid & 63, wave = __builtin_amdgcn_readfirstlane(tid >> 6);
    const Ptrs& P = args.p;
    unsigned char* ws = P.ws;
    gu32* ctl = (gu32*)(ws + WS_CTL);
    for (int u = tid; u < (LDS_BYTES - LDSCTL_OFF) / 4; u += NWAVES * 64) ((LAS unsigned*)(lds + LDSCTL_OFF))[u] = 0u;
    __syncthreads();
    const int lo = args.ph_lo, hi = args.ph_hi;
    XcdBarrier bar; bar.bar = (unsigned*)(ctl + CW_BAR); bar.x = 0; bar.st = nullptr;
    if (hi - lo > 1) bar = xcd_barrier_post((unsigned*)(ctl + CW_BAR), MISC + 8);
#define IN(k) (lo <= (k) && (k) < hi)
#define SEAM(k) do { if (IN(k) && IN((k) + 1)) xcd_barrier(bar); } while (0)
    bf16* hb = (bf16*)(ws + WS_HB); bf16* ob = (bf16*)(ws + WS_OB); bf16* act = (bf16*)(ws + WS_ACT); float* part = (float*)(ws + WS_PART);
    const int G = gridDim.x, bx = blockIdx.x;

#ifndef DUP_MASK
#define DUP_MASK 0u
#endif
#ifndef EXTRA_BARS
#define EXTRA_BARS 0
#endif
#define DUP(k) ((DUP_MASK >> (k)) & 1u)
    if (IN(0)) { if (DUP(0)) { p0_prologue(P, lds, wave, lane); xcd_barrier(bar); } p0_prologue(P, lds, wave, lane); } SEAM(0);
    for (int eb_ = 0; eb_ < EXTRA_BARS; ++eb_) xcd_barrier(bar);
#define WFIN(i) ((const bf16*)(ws + WS_WFIN) + (size_t)(i) * 2 * FF * DM)
#define WFOUT(i) ((const bf16*)(ws + WS_WFOUT) + (size_t)(i) * DM * FF)
#define PH_FFN_IN(k, wi) do { if (IN(k)) for (int rep_ = DUP(k) ? 2 : 1; rep_ > 0; --rep_) { if (rep_ == 1 && DUP(k)) xcd_barrier(bar); pg8::Gemm g{hb, WFIN(wi), M, 2 * FF, DM}; pg8::StaticOrder S; S.init(M, 2 * FF, G, bx); \
        pg8::EpiSwiglu E{act, FF, part}; pg8::gemm_phase<pg8::EpiSwiglu, pg8::StaticOrder, true, true>(lds + RING_OFF, g, S, E); } SEAM(k); } while (0)
#define PH_FFN_OUT_(k, wi, obp, partp) do { pg8::Gemm g{act, WFOUT(wi), M, DM, FF}; pg8::StaticOrder S; S.init(M, DM, G, bx); \
        pg8::EpiResid E{hb, obp, partp, 0.5f}; pg8::gemm_phase<pg8::EpiResid, pg8::StaticOrder, true, true>(lds + RING_OFF, g, S, E); } while (0)
#define PH_FFN_OUT(k, wi) do { if (IN(k)) { if (DUP(k)) { PH_FFN_OUT_(k, wi, ob, (float*)(ws + WS_END)); xcd_barrier(bar); } PH_FFN_OUT_(k, wi, hb, part); } SEAM(k); } while (0)
#define PH_MIX_IN(k, woff, NN) do { if (IN(k)) for (int rep_ = DUP(k) ? 2 : 1; rep_ > 0; --rep_) { if (rep_ == 1 && DUP(k)) xcd_barrier(bar); pg8::Gemm g{hb, (const bf16*)(ws + (woff)), M, NN, DM}; pg8::StaticOrder S; S.init(M, NN, G, bx); \
        pg8::EpiRowScale E{act, NN, part}; pg8::gemm_phase<pg8::EpiRowScale, pg8::StaticOrder, true, true>(lds + RING_OFF, g, S, E); } SEAM(k); } while (0)
#define PH_MIX_OUT_(k, woff, obp, partp) do { pg8::Gemm g{ob, (const bf16*)(ws + (woff)), M, DM, DM}; pg8::StaticOrder S; S.init(M, DM, G, bx); \
        pg8::EpiResid E{hb, obp, partp, 1.0f}; pg8::gemm_phase<pg8::EpiResid, pg8::StaticOrder, true, true>(lds + RING_OFF, g, S, E); } while (0)
#define PH_MIX_OUT(k, woff) do { if (IN(k)) { if (DUP(k)) { PH_MIX_OUT_(k, woff, act, (float*)(ws + WS_END)); xcd_barrier(bar); } PH_MIX_OUT_(k, woff, hb, part); } SEAM(k); } while (0)
    PH_FFN_IN(1, 0); PH_FFN_OUT(2, 0);
    PH_MIX_IN(3, WS_WAIN, AIN);
    if (IN(4)) { if (DUP(4)) { attn_phase(P, lds, wave, lane); xcd_barrier(bar); } attn_phase(P, lds, wave, lane); } SEAM(4);
    PH_MIX_OUT(5, WS_WAOUT);
    PH_FFN_IN(6, 1); PH_FFN_OUT(7, 1);
    PH_FFN_IN(8, 2); PH_FFN_OUT(9, 2);
    PH_MIX_IN(10, WS_WRIN, RIN);
    if (IN(11)) { if (DUP(11)) { rec_pass_a(P, lds, wave, lane); xcd_barrier(bar); } rec_pass_a(P, lds, wave, lane); } SEAM(11);
    if (IN(12)) { if (DUP(12)) { rec_pass_b(P); xcd_barrier(bar); } rec_pass_b(P); } SEAM(12);
    if (IN(13)) { if (DUP(13)) { rec_pass_c(P, lds, wave, lane); xcd_barrier(bar); } rec_pass_c(P, lds, wave, lane); } SEAM(13);
    PH_MIX_OUT(14, WS_WROUT);
    PH_FFN_IN(15, 3); PH_FFN_OUT(16, 3);
    if (IN(N_PHASES - 1)) final_norm(P, wave, lane);
#undef IN
#undef SEAM
}

#ifndef MK_PER_PHASE
#define MK_PER_PHASE 0
#endif
extern "C" void kernel_launch(void* const* d_in, const int* in_sizes, int n_in, void* d_out, int out_size, void* d_ws, size_t ws_size, hipStream_t stream) {
    static int grid = 0;
    if (grid == 0) {
        if (n_in != 13 || in_sizes[0] != M * DM || out_size != M * DM || ws_size < WS_END + MiB) { fprintf(stderr, "kernel_launch: unexpected shapes (n_in %d, in0 %d, out %d, ws %zu); nothing launched\n", n_in, n_in > 0 ? in_sizes[0] : -1, out_size, ws_size); grid = -1; return; }
        int dev = 0, cus = 0, per_cu = 0;
        if (hipGetDevice(&dev) != hipSuccess || hipDeviceGetAttribute(&cus, hipDeviceAttributeMultiprocessorCount, dev) != hipSuccess) { grid = -1; return; }
        if (hipFuncSetAttribute((const void*)trunk_fwd, hipFuncAttributeMaxDynamicSharedMemorySize, LDS_BYTES) != hipSuccess) { fprintf(stderr, "kernel_launch: hipFuncSetAttribute failed\n"); grid = -1; return; }
        if (hipOccupancyMaxActiveBlocksPerMultiprocessor(&per_cu, (const void*)trunk_fwd, NWAVES * 64, LDS_BYTES) != hipSuccess || per_cu < 1) { fprintf(stderr, "kernel_launch: occupancy query says %d blocks per CU\n", per_cu); per_cu = 1; }
        (void)hipGetLastError();
        grid = cus;
    }
    if (grid < 0) return;
    (void)hipMemsetAsync((char*)d_ws + WS_CTL, 0, CTL_ZERO_BYTES, stream);
    Args a{};
    const float** pp = (const float**)&a.p;
    for (int i = 0; i < 13; ++i) pp[i] = (const float*)d_in[i];
    a.p.out = (float*)d_out; a.p.ws = (unsigned char*)d_ws;
#if MK_PER_PHASE
    for (int k = 0; k < N_PHASES; ++k) { a.ph_lo = k; a.ph_hi = k + 1; hipLaunchKernelGGL(trunk_fwd, dim3(grid), dim3(NWAVES * 64), LDS_BYTES, stream, a); }
#else
    a.ph_lo = 0; a.ph_hi = N_PHASES; hipLaunchKernelGGL(trunk_fwd, dim3(grid), dim3(NWAVES * 64), LDS_BYTES, stream, a);
#endif
}
```

```cpp
#include <hip/hip_runtime.h>
#include <cstdio>
#include <cstdint>
namespace pg8 {
#define PG8_LAS __attribute__((address_space(3)))
typedef unsigned short bf16_t;
typedef short bf16x8 __attribute__((ext_vector_type(8)));
typedef float f32x4 __attribute__((ext_vector_type(4)));
typedef unsigned u32x4 __attribute__((ext_vector_type(4)));
constexpr int BM = 256, BK = 64, HALF = 128, HTB = HALF * BK * 2  , STAGE_BYTES = 8 * HTB, NXCD = 8, WGM = 8;

__host__ __device__ __forceinline__ int lds_byte(int r, int c) { const int st = (r >> 4) * 2 + (c >> 5), rr = r & 15, cc = c & 31, ob = rr * 64 + cc * 2; return st * 1024 + (ob ^ (((ob >> 9) & 1) << 5)); }
__host__ __device__ __forceinline__ void stage_rc(int b, int& R, int& C) { const int st = b / 1024, sb = b % 1024, swz = sb ^ (((sb >> 9) & 1) << 5); R = (st >> 1) * 16 + swz / 64; C = (st & 1) * 32 + (swz % 64) / 2; }
__host__ __device__ __forceinline__ int perm32(int rho) { const int n = rho >> 4, i = rho & 15; return 8 * (i >> 2) + 4 * n + (i & 3); }

struct Unit { int pm, pn; };
struct Gemm { const bf16_t* A; const bf16_t* Bt; int M, N, K; };

struct StaticOrder {
    int nM, nN, nwg, G, c;
    __host__ __device__ void init(int M, int N, int G_, int c_) { nM = M / BM; nN = N / BM; nwg = nM * nN; G = G_; c = c_; }
    __host__ __device__ bool next(int i, Unit& u) const {
        const long L = (long)i * G + c; if (L >= nwg) return false;
        int wgid = (int)L; { const int q = nwg / NXCD, r = nwg % NXCD, xcd = wgid % NXCD, off = wgid / NXCD; wgid = (xcd < r ? xcd * (q + 1) : r * (q + 1) + (xcd - r) * q) + off; }
        const int nig = WGM * nN, gid = wgid / nig, fm = gid * WGM, gsz = (nM - fm) < WGM ? (nM - fm) : WGM;
        u.pm = fm + ((wgid % nig) % gsz); u.pn = (wgid % nig) / gsz; return true;
    }
    __device__ __forceinline__ void a_ready(const Unit&) const {}
    __device__ __forceinline__ void done(const Unit&) const {}
};
typedef float f32x2_t __attribute__((ext_vector_type(2))); typedef __bf16 bf16x2_t __attribute__((ext_vector_type(2)));
__device__ __forceinline__ unsigned cvt_pk_bf16(float lo, float hi) { f32x2_t v = {lo, hi}; bf16x2_t b = __builtin_convertvector(v, bf16x2_t); return __builtin_bit_cast(unsigned, b); }
__device__ __forceinline__ u32x4 pack8(const f32x4 a, const f32x4 b) { u32x4 w; w.x = cvt_pk_bf16(a[0], a[1]); w.y = cvt_pk_bf16(a[2], a[3]); w.z = cvt_pk_bf16(b[0], b[1]); w.w = cvt_pk_bf16(b[2], b[3]); return w; }
constexpr float RMS_EPS = 1e-6f;
__device__ __forceinline__ float row_rstd(const float* part, int row, int fq) {
    const f32x4 p = *(const f32x4*)(part + (size_t)row * 16 + fq * 4);
    float s = (p[0] + p[1]) + (p[2] + p[3]);
    s += __shfl_xor(s, 16); s += __shfl_xor(s, 32);
    return 1.0f / sqrtf(s * (1.0f / 1024.0f) + RMS_EPS);
}
__device__ __forceinline__ float silu_f(float x) { return x * __builtin_amdgcn_rcpf(1.0f + __expf(-x)); }
struct EpiRowScale {
    static constexpr bool PERM = true, AFTER_DRAIN = false;
    bf16_t* O; int ldc; const float* part;
    __device__ __forceinline__ void operator()(const f32x4 (&acc)[2][2][4][2], const Unit& u, int wr, int wc, int fr, int fq) const {
        const int row0 = u.pm * BM + wr * 64 + fr, col0 = u.pn * BM + wc * 32 + 8 * fq;
#pragma unroll
        for (int ai = 0; ai < 2; ++ai)
#pragma unroll
            for (int m = 0; m < 4; ++m) { const int row = row0 + ai * HALF + m * 16; const float r = row_rstd(part, row, fq);
                bf16_t* rowp = O + (size_t)row * ldc + col0;
#pragma unroll
                for (int bj = 0; bj < 2; ++bj) *(u32x4*)(rowp + bj * HALF) = pack8(acc[ai][bj][m][0] * r, acc[ai][bj][m][1] * r);
                asm volatile("" ::: "memory"); }
    }
};
template <int MODE = 0  > struct EpiSwigluT {
    static constexpr bool PERM = true, AFTER_DRAIN = false;
    bf16_t* O; int ldc; const float* part;
    __device__ __forceinline__ void operator()(const f32x4 (&acc)[2][2][4][2], const Unit& u, int wr, int wc, int fr, int fq) const {
        const int row0 = u.pm * BM + wr * 64 + fr, col0 = u.pn * HALF + wc * 32 + 8 * fq;
        if (MODE == 2) {
#pragma unroll
            for (int ai = 0; ai < 2; ++ai)
#pragma unroll
                for (int bj = 0; bj < 2; ++bj)
#pragma unroll
                    for (int m = 0; m < 4; ++m)
#pragma unroll
                        for (int n = 0; n < 2; ++n) asm volatile("" :: "v"(acc[ai][bj][m][n]));
            return; }
#pragma unroll
        for (int ai = 0; ai < 2; ++ai)
#pragma unroll
            for (int m = 0; m < 4; ++m) { const int row = row0 + ai * HALF + m * 16; const float r = row_rstd(part, row, fq);
                f32x4 o[2];
#pragma unroll
                for (int n = 0; n < 2; ++n) { const f32x4 g = acc[ai][0][m][n] * r, up = acc[ai][1][m][n] * r;
#pragma unroll
                    for (int i = 0; i < 4; ++i) o[n][i] = silu_f(g[i]) * up[i]; }
                const u32x4 pk = pack8(o[0], o[1]);
                if (MODE == 1) asm volatile("" :: "v"(pk)); else *(u32x4*)(O + (size_t)row * ldc + col0) = pk;
                asm volatile("" ::: "memory"); }
    }
};
typedef EpiSwigluT<0> EpiSwiglu;
__device__ __forceinline__ f32x4 bf2x_lo(unsigned a, unsigned b) { f32x4 r; r[0] = __uint_as_float(a << 16); r[1] = __uint_as_float(a & 0xffff0000u); r[2] = __uint_as_float(b << 16); r[3] = __uint_as_float(b & 0xffff0000u); return r; }
struct EpiResid {
    static constexpr bool PERM = true, AFTER_DRAIN = false;
    const bf16_t* base; bf16_t* ob; float* part; float scale;
    __device__ __forceinline__ void operator()(const f32x4 (&acc)[2][2][4][2], const Unit& u, int wr, int wc, int fr, int fq) const {
        const int row0 = u.pm * BM + wr * 64 + fr, col0 = u.pn * BM + wc * 32 + 8 * fq;
#pragma unroll
        for (int ai = 0; ai < 2; ++ai)
#pragma unroll
            for (int m = 0; m < 4; ++m) { const int row = row0 + ai * HALF + m * 16; const size_t off = (size_t)row * 1024 + col0; float ss = 0.f;
#pragma unroll
                for (int bj = 0; bj < 2; ++bj) { const u32x4 bw = *(const u32x4*)(base + off + bj * HALF);
                    const f32x4 h0 = bf2x_lo(bw.x, bw.y) + acc[ai][bj][m][0] * scale, h1 = bf2x_lo(bw.z, bw.w) + acc[ai][bj][m][1] * scale;
                    *(u32x4*)(ob + off + bj * HALF) = pack8(h0, h1);
                    ss += (h0[0] * h0[0] + h0[1] * h0[1]) + (h0[2] * h0[2] + h0[3] * h0[3]) + (h1[0] * h1[0] + h1[1] * h1[1]) + (h1[2] * h1[2] + h1[3] * h1[3]); }
                ss += __shfl_xor(ss, 16); ss += __shfl_xor(ss, 32);
                if (fq == 0) part[(size_t)row * 16 + u.pn * 4 + wc] = ss;
                asm volatile("" ::: "memory"); }
    }
};

template <class Epi, class Sched, bool ALIGN_EPI = false, bool SP2 = false>
__device__ __forceinline__ void gemm_phase(PG8_LAS unsigned char* lds, const Gemm g, const Sched& S, const Epi& E) {
    const int tid = threadIdx.x, wid = __builtin_amdgcn_readfirstlane(tid >> 6), lane = tid & 63, wr = wid >> 2, wc = wid & 3, fr = lane & 15, fq = lane >> 4;
    const int K = g.K, nt = K / BK;
    unsigned voffA[2], voffB[2];
#pragma unroll
    for (int i = 0; i < 2; ++i) { int R, C; stage_rc(tid * 16 + i * 8192, R, C); const int Rb = Epi::PERM ? ((R & ~31) + perm32(R & 31)) : R;
        voffA[i] = (unsigned)(R * K + C) * 2u; voffB[i] = (unsigned)(Rb * K + C) * 2u; }
    const size_t kstep = (size_t)(BK * 2);
    const size_t hstep = (size_t)HALF * K * 2;
    const size_t tstep = 2 * hstep;
    const unsigned ldsw = (unsigned)wid * 1024u;
    const int aoff = lds_byte(wr * 64 + fr, fq * 8), boff = lds_byte(wc * 32 + fr, fq * 8);
#define PG8_SA(b, h) (((b) * 2 + (h)) * HTB)
#define PG8_SB(b, h) ((4 + (b) * 2 + (h)) * HTB)
#define PG8_STAGE(bufoff, gbase, voff) do { _Pragma("unroll") for (int _i = 0; _i < 2; ++_i) \
        __builtin_amdgcn_global_load_lds((const unsigned*)((const char*)(gbase) + (voff)[_i]), (PG8_LAS unsigned*)(lds + (bufoff) + ldsw + _i * 8192), 16, 0, 0); } while (0)
#define PG8_LDA(dst, b, h) do { _Pragma("unroll") for (int m = 0; m < 4; ++m) _Pragma("unroll") for (int k = 0; k < 2; ++k) dst[m][k] = *(const PG8_LAS bf16x8*)(lds + PG8_SA(b, h) + aoff + m * 2048 + k * 1024); } while (0)
#define PG8_LDB(dst, b, h) do { _Pragma("unroll") for (int n = 0; n < 2; ++n) _Pragma("unroll") for (int k = 0; k < 2; ++k) dst[n][k] = *(const PG8_LAS bf16x8*)(lds + PG8_SB(b, h) + boff + n * 2048 + k * 1024); } while (0)
#define PG8_MMA(ai, bj, At, Bt) do { __builtin_amdgcn_s_setprio(1); _Pragma("unroll") for (int m = 0; m < 4; ++m) _Pragma("unroll") for (int n = 0; n < 2; ++n) _Pragma("unroll") for (int k = 0; k < 2; ++k) \
        acc[ai][bj][m][n] = __builtin_amdgcn_mfma_f32_16x16x32_bf16(Bt[n][k], At[m][k], acc[ai][bj][m][n], 0, 0, 0); __builtin_amdgcn_s_setprio(0); } while (0)
#define PG8_WAIT_V(n) asm volatile("s_waitcnt vmcnt(" #n ")" ::: "memory")
#define PG8_WAIT_L(n) asm volatile("s_waitcnt lgkmcnt(" #n ")" ::: "memory")
#define PG8_BAR __builtin_amdgcn_s_barrier()
#define PG8_SCHED __builtin_amdgcn_sched_barrier(0)
    Unit cur, nxt; int ui = 0;
    if (!S.next(0, cur)) return;
    f32x4 acc[2][2][4][2];
#pragma unroll
    for (int a = 0; a < 2; ++a)
#pragma unroll
        for (int b = 0; b < 2; ++b)
#pragma unroll
            for (int m = 0; m < 4; ++m)
#pragma unroll
                for (int n = 0; n < 2; ++n) acc[a][b][m][n] = (f32x4){0.f, 0.f, 0.f, 0.f};
    bf16x8 At[4][2], B0[2][2], B1[2][2];
    const char* cA = (const char*)g.A + (size_t)cur.pm * tstep; const char* cB = (const char*)g.Bt + (size_t)cur.pn * tstep;
    S.a_ready(cur);
    if constexpr (SP2) {
        PG8_STAGE(PG8_SB(0, 0), cB, voffB); PG8_STAGE(PG8_SB(0, 1), cB + hstep, voffB); PG8_STAGE(PG8_SA(0, 0), cA, voffA); PG8_STAGE(PG8_SA(0, 1), cA + hstep, voffA);
        if (wr == 1) PG8_BAR;
        PG8_WAIT_V(2); PG8_BAR;
        PG8_STAGE(PG8_SB(1, 0), cB + kstep, voffB); PG8_STAGE(PG8_SA(1, 0), cA + kstep, voffA); PG8_STAGE(PG8_SB(1, 1), cB + hstep + kstep, voffB);
        PG8_WAIT_V(6); PG8_BAR;
    } else {
        PG8_STAGE(PG8_SB(0, 0), cB, voffB); PG8_STAGE(PG8_SA(0, 0), cA, voffA); PG8_STAGE(PG8_SB(0, 1), cB + hstep, voffB); PG8_STAGE(PG8_SA(0, 1), cA + hstep, voffA);
        if (wr == 1) PG8_BAR;
        PG8_WAIT_V(4); PG8_BAR;
        PG8_STAGE(PG8_SB(1, 0), cB + kstep, voffB); PG8_STAGE(PG8_SA(1, 0), cA + kstep, voffA); PG8_STAGE(PG8_SB(1, 1), cB + hstep + kstep, voffB);
        PG8_WAIT_V(6); PG8_BAR;
    }
    for (;;) {
        const bool has_next = S.next(ui + 1, nxt);
        const char* nA = has_next ? (const char*)g.A + (size_t)nxt.pm * tstep : cA; const char* nB = has_next ? (const char*)g.Bt + (size_t)nxt.pn * tstep : cB;
        for (int t = 0; t < nt; t += 2) {
            const bool last = (t == nt - 2);
            const char* a1 = cA + (size_t)(t + 1) * kstep;
            const char* a2 = last ? nA : cA + (size_t)(t + 2) * kstep; const char* b2 = last ? nB : cB + (size_t)(t + 2) * kstep;
            const char* a3 = a2 + kstep; const char* b3 = b2 + kstep;
            if (last && has_next) S.a_ready(nxt);
            if constexpr (SP2) {
            PG8_LDB(B0, 0, 0); PG8_LDB(B1, 0, 1); PG8_SCHED; PG8_LDA(At, 0, 0); PG8_STAGE(PG8_SA(1, 1), a1 + hstep, voffA);
            PG8_WAIT_V(8); PG8_WAIT_L(0); PG8_BAR; PG8_MMA(0, 0, At, B0); PG8_MMA(0, 1, At, B1); PG8_BAR; PG8_SCHED;
            PG8_LDA(At, 0, 1); PG8_STAGE(PG8_SB(0, 0), b2, voffB); PG8_STAGE(PG8_SB(0, 1), b2 + hstep, voffB); PG8_STAGE(PG8_SA(0, 0), a2, voffA);
            PG8_WAIT_V(8); PG8_WAIT_L(0); PG8_BAR; PG8_MMA(1, 0, At, B0); PG8_MMA(1, 1, At, B1); PG8_BAR; PG8_SCHED;
            PG8_LDB(B0, 1, 0); PG8_LDB(B1, 1, 1); PG8_SCHED; PG8_LDA(At, 1, 0); PG8_STAGE(PG8_SA(0, 1), a2 + hstep, voffA);
            PG8_WAIT_V(8); PG8_WAIT_L(0); PG8_BAR; PG8_MMA(0, 0, At, B0); PG8_MMA(0, 1, At, B1); PG8_BAR; PG8_SCHED;
            PG8_LDA(At, 1, 1); PG8_STAGE(PG8_SB(1, 0), b3, voffB); PG8_STAGE(PG8_SB(1, 1), b3 + hstep, voffB); PG8_STAGE(PG8_SA(1, 0), a3, voffA);
            PG8_WAIT_V(8); PG8_WAIT_L(0); PG8_BAR; PG8_MMA(1, 0, At, B0); PG8_MMA(1, 1, At, B1); PG8_BAR; PG8_SCHED;
            } else {
            PG8_LDB(B0, 0, 0); PG8_SCHED; PG8_LDA(At, 0, 0); PG8_STAGE(PG8_SA(1, 1), a1 + hstep, voffA);
            PG8_WAIT_L(8); PG8_BAR; PG8_WAIT_L(0); PG8_MMA(0, 0, At, B0); PG8_BAR; PG8_SCHED;
            PG8_LDB(B1, 0, 1); PG8_STAGE(PG8_SB(0, 0), b2, voffB);
            PG8_BAR; PG8_WAIT_L(0); PG8_MMA(0, 1, At, B1); PG8_BAR;
            PG8_LDA(At, 0, 1); PG8_STAGE(PG8_SA(0, 0), a2, voffA);
            PG8_BAR; PG8_WAIT_L(0); PG8_MMA(1, 0, At, B0); PG8_BAR; PG8_SCHED;
            PG8_STAGE(PG8_SB(0, 1), b2 + hstep, voffB);
            PG8_WAIT_V(6); PG8_BAR; PG8_MMA(1, 1, At, B1); PG8_BAR;
            PG8_LDB(B0, 1, 0); PG8_SCHED; PG8_LDA(At, 1, 0); PG8_STAGE(PG8_SA(0, 1), a2 + hstep, voffA);
            PG8_WAIT_L(8); PG8_BAR; PG8_WAIT_L(0); PG8_MMA(0, 0, At, B0); PG8_BAR; PG8_SCHED;
            PG8_LDB(B1, 1, 1); PG8_STAGE(PG8_SB(1, 0), b3, voffB);
            PG8_BAR; PG8_WAIT_L(0); PG8_MMA(0, 1, At, B1); PG8_BAR;
            PG8_LDA(At, 1, 1); PG8_STAGE(PG8_SA(1, 0), a3, voffA);
            PG8_BAR; PG8_WAIT_L(0); PG8_MMA(1, 0, At, B0); PG8_BAR; PG8_SCHED;
            PG8_STAGE(PG8_SB(1, 1), b3 + hstep, voffB);
            PG8_WAIT_V(6); PG8_BAR; PG8_MMA(1, 1, At, B1); PG8_BAR;
            }
        }
        if constexpr (ALIGN_EPI) { if (wr == 0) PG8_BAR; }
        if constexpr (!Epi::AFTER_DRAIN) { E(acc, cur, wr, wc, fr, fq); S.done(cur); }
        if (!has_next) break;
#pragma unroll
        for (int a = 0; a < 2; ++a)
#pragma unroll
            for (int b = 0; b < 2; ++b)
#pragma unroll
                for (int m = 0; m < 4; ++m)
#pragma unroll
                    for (int n = 0; n < 2; ++n) acc[a][b][m][n] = (f32x4){0.f, 0.f, 0.f, 0.f};
        cur = nxt; cA = nA; cB = nB; ++ui;
        if constexpr (ALIGN_EPI) { if (wr == 1) PG8_BAR; }
    }
    PG8_WAIT_V(0);
    if constexpr (!ALIGN_EPI) { if (wr == 0) PG8_BAR; }
    PG8_BAR;
    if constexpr (Epi::AFTER_DRAIN) { E.fused(acc, cur, wr, wc, fr, fq, lds, wid, lane); S.done(cur); }
#undef PG8_SA
#undef PG8_SB
#undef PG8_STAGE
#undef PG8_LDA
#undef PG8_LDB
#undef PG8_MMA
#undef PG8_WAIT_V
#undef PG8_WAIT_L
#undef PG8_BAR
#undef PG8_SCHED
}
}

constexpr int NWAVES = 8;
constexpr int BATCH = 8, SEQ = 2048, DM = 1024, FF = 2816, M = BATCH * SEQ;
constexpr int AIN = 2304, RIN = 3584;
constexpr float SB_EXIT = -105.0f;

constexpr size_t MiB = 1u << 20;
constexpr size_t WS_CTL = 0, CTL_ZERO_BYTES = 1 * MiB;
constexpr size_t WS_WFIN = 2 * MiB;
constexpr size_t WS_WFOUT = 46 * MiB;
constexpr size_t WS_WAIN = 68 * MiB, WS_WAOUT = 73 * MiB, WS_WRIN = 75 * MiB, WS_WROUT = 82 * MiB;
constexpr size_t WS_PART = 84 * MiB;
constexpr size_t WS_DEC = 85 * MiB;
constexpr size_t WS_HB = 86 * MiB;
constexpr size_t WS_SB = WS_WFIN;
constexpr size_t WS_OB = 118 * MiB;
constexpr size_t WS_ACT = 150 * MiB;
constexpr size_t WS_ST = 262 * MiB;
constexpr size_t WS_END = 326 * MiB;
constexpr int CW_BAR = 4096;

constexpr int RING_OFF = 0, RING_BYTES = 131072;
constexpr int LDSCTL_OFF = RING_BYTES, MISC_OFF = LDSCTL_OFF + 320;
constexpr int LDS_BYTES = 147456;

#define GAS __attribute__((address_space(1)))
#define LAS __attribute__((address_space(3)))
typedef unsigned short bf16;
typedef unsigned v4u __attribute__((ext_vector_type(4)));
typedef float f32x4 __attribute__((ext_vector_type(4)));
typedef short bf16x8 __attribute__((ext_vector_type(8)));
typedef GAS unsigned gu32;
typedef GAS unsigned long long gu64;
#define RLX_AGENT __ATOMIC_RELAXED, __HIP_MEMORY_SCOPE_AGENT
#define LDS_WAIT() asm volatile("s_waitcnt lgkmcnt(0)" ::: "memory")
#define VM_WAIT() asm volatile("s_waitcnt vmcnt(0)" ::: "memory")
__device__ __forceinline__ unsigned long long rt() { return __builtin_amdgcn_s_memrealtime(); }
__device__ __forceinline__ unsigned f2bf(float f) { unsigned u = __builtin_bit_cast(unsigned, f); return (u + 0x7fffu + ((u >> 16) & 1u)) >> 16; }
__device__ __forceinline__ unsigned pk2(float lo, float hi) { return f2bf(lo) | (f2bf(hi) << 16); }

#define XB_TMO      128
#define XB_XCNT(j)  (256  + 64 * (j))
#define XB_XSUB(j)  (1280 + 64 * (j))
#define XB_XGEN(j)  (2304 + 64 * (j))
#define XB_TOP      3328
#define XB_TOPGEN   3392
#define XCD_BAR_WORDS 3456
#define XB_SPIN_CAP (1u << 18)

__device__ __forceinline__ unsigned xb_ld(unsigned* p)              { return __hip_atomic_load(p, __ATOMIC_RELAXED, __HIP_MEMORY_SCOPE_AGENT); }
__device__ __forceinline__ unsigned xb_add(unsigned* p, unsigned v) { return __hip_atomic_fetch_add(p, v, __ATOMIC_RELAXED, __HIP_MEMORY_SCOPE_AGENT); }
__device__ __forceinline__ unsigned xb_xcc_id() { return (unsigned)__builtin_amdgcn_s_getreg((3 << 11) | 20) & 0xFu; }
#define XB_SPIN(cond, bar) do { unsigned _sp = 0; while (cond) { __builtin_amdgcn_s_sleep(1); \
    if ((++_sp & 255u) == 0u) { if (xb_ld(&(bar)[XB_TMO])) break; if (_sp > XB_SPIN_CAP) { atomicAdd(&(bar)[XB_TMO], 1u); break; } } } } while (0)

struct XcdBarrier {
    unsigned* bar; unsigned x;
    volatile LAS unsigned* st;
};

__device__ __forceinline__ XcdBarrier xcd_barrier_post(unsigned* bar, volatile LAS unsigned* st) {
    XcdBarrier b; b.bar = bar; b.x = xb_xcc_id(); b.st = st;
    if (threadIdx.x == 0) (void)xb_add(&bar[XB_XCNT(b.x)], 1u);
    return b;
}
__device__ __forceinline__ void xcd_barrier_complete(unsigned* bar, unsigned x, unsigned& nloc, unsigned& nx) {
    const unsigned G = gridDim.x * gridDim.y * gridDim.z;
    unsigned sum, cnt, mine, sp = 0u;
    for (;;) {
        sum = 0u; cnt = 0u; mine = 0u;
#pragma unroll
        for (unsigned j = 0; j < 16; ++j) { const unsigned c = xb_ld(&bar[XB_XCNT(j)]); sum += c; cnt += (c > 0u) ? 1u : 0u; mine = (j == x) ? c : mine; }
        if (sum == G) break;
        __builtin_amdgcn_s_sleep(1);
        if ((++sp & 255u) == 0u) { if (xb_ld(&bar[XB_TMO])) break; if (sp > XB_SPIN_CAP) { atomicAdd(&bar[XB_TMO], 1u); break; } }
    }
    nloc = mine > 0u ? mine : 1u; nx = cnt > 0u ? cnt : 1u;
}

__device__ __forceinline__ void xcd_barrier(const XcdBarrier& b) {
    asm volatile("s_waitcnt vmcnt(0)" ::: "memory");
    __syncthreads();
    if (threadIdx.x == 0) {
        unsigned* bar = b.bar;
        __builtin_amdgcn_s_waitcnt(0);
        unsigned nloc = b.st[0], nx = b.st[1];
        if (nloc == 0u) { xcd_barrier_complete(bar, b.x, nloc, nx); b.st[0] = nloc; b.st[1] = nx; }
        const unsigned old = xb_add(&bar[XB_XSUB(b.x)], 1u);
        const unsigned gen = old / nloc;
        if (old + 1u == (gen + 1u) * nloc) {
            __builtin_amdgcn_fence(__ATOMIC_RELEASE, "agent");
            asm volatile("s_waitcnt vmcnt(0)" ::: "memory");
            const unsigned og = xb_add(&bar[XB_TOP], 1u);
            const unsigned tg = og / nx;
            if (og + 1u == (tg + 1u) * nx) xb_add(&bar[XB_TOPGEN], 1u);
            else XB_SPIN(xb_ld(&bar[XB_TOPGEN]) == tg, bar);
            __builtin_amdgcn_fence(__ATOMIC_ACQUIRE, "agent");
            xb_add(&bar[XB_XGEN(b.x)], 1u);
            asm volatile("s_waitcnt vmcnt(0)" ::: "memory");
        } else {
            XB_SPIN(xb_ld(&bar[XB_XGEN(b.x)]) == gen, bar);
            __builtin_amdgcn_fence(__ATOMIC_ACQUIRE, "agent");
            asm volatile("s_waitcnt vmcnt(0)" ::: "memory");
        }
    }
    __syncthreads();
}


typedef float f32x16 __attribute__((ext_vector_type(16)));
typedef unsigned u32x2v __attribute__((ext_vector_type(2)));
__device__ __forceinline__ float bf2f(unsigned short v) { return __uint_as_float((unsigned)v << 16); }
__device__ __forceinline__ int crow(int r, int hi) { return (r & 3) + 8 * (r >> 2) + 4 * hi; }
__device__ __forceinline__ int swap23(int k) { return (k & ~12) | ((k & 4) << 1) | ((k & 8) >> 1); }
#define MFMA32(a, b, c) __builtin_amdgcn_mfma_f32_32x32x16_bf16((a), (b), (c), 0, 0, 0)
__device__ __forceinline__ bf16x8 packf8(float a0, float a1, float a2, float a3, float a4, float a5, float a6, float a7) {
    v4u w; w.x = pg8::cvt_pk_bf16(a0, a1); w.y = pg8::cvt_pk_bf16(a2, a3); w.z = pg8::cvt_pk_bf16(a4, a5); w.w = pg8::cvt_pk_bf16(a6, a7); return __builtin_bit_cast(bf16x8, w); }
__device__ __forceinline__ float wave_sum(float v) {
#pragma unroll
    for (int o = 1; o < 64; o <<= 1) v += __shfl_xor(v, o);
    return v;
}

__device__ __forceinline__ void p0_item(const float* W, int K, int N, bf16* WT, const float* gain, bool swg, LAS float* scr, int item, int lane) {
    const int nblk = N / 32, kb = item / nblk, nb = item % nblk, k0 = 64 * kb, n0 = 32 * nb;
    int sn0 = n0; if (swg) { const int pn = n0 >> 8, bj = (n0 >> 7) & 1, x0 = n0 & 127; sn0 = bj * FF + pn * 128 + x0; }
    const float gl = gain ? gain[k0 + lane] : 1.0f;
    float wv[32];
#pragma unroll
    for (int i = 0; i < 32; ++i) wv[i] = W[(size_t)(k0 + 2 * i + (lane >> 5)) * N + sn0 + (lane & 31)];
#pragma unroll
    for (int i = 0; i < 32; ++i) { const int kk = 2 * i + (lane >> 5); scr[kk * 33 + (lane & 31)] = wv[i] * __shfl(gl, kk); }
    LDS_WAIT(); asm volatile("" ::: "memory");
    const int c = lane & 7;
#pragma unroll
    for (int j = 0; j < 4; ++j) { const int n = (lane >> 3) + 8 * j; const LAS float* s = scr + (8 * c) * 33 + n;
        v4u o; o.x = pk2(s[0 * 33], s[1 * 33]); o.y = pk2(s[2 * 33], s[3 * 33]); o.z = pk2(s[4 * 33], s[5 * 33]); o.w = pk2(s[6 * 33], s[7 * 33]);
        *(GAS v4u*)(WT + (size_t)(n0 + n) * K + k0 + 8 * c) = o; }
    LDS_WAIT(); asm volatile("" ::: "memory");
}

struct Ptrs {
    const float *x, *norm_g, *ffn_w_in, *ffn_w_out, *attn_w_in, *attn_sinks, *attn_w_out, *rec_w_in, *lb_logits, *hgrn_norm_g, *conv_w, *rec_w_out, *final_g;
    float* out; unsigned char* ws;
};

constexpr int I_FIN = (DM / 64) * (2 * FF / 32), I_FOUT = (FF / 64) * (DM / 32), I_AIN = (DM / 64) * (AIN / 32), I_O = (DM / 64) * (DM / 32), I_RIN = (DM / 64) * (RIN / 32);
__host__ __device__ constexpr int conv_items_of(int id) { return id < 0 ? 0 : id < 4 ? I_FIN : id < 8 ? I_FOUT : id == 8 ? I_AIN : id == 10 ? I_RIN : I_O; }
__device__ __forceinline__ void conv_item(const Ptrs& P, int id, int r, LAS float* scr, int lane) {
    unsigned char* ws = P.ws;
    if (id < 4) { const int w = id, l = w >> 1, j = w & 1; p0_item(P.ffn_w_in + (size_t)w * DM * 2 * FF, DM, 2 * FF, (bf16*)(ws + WS_WFIN) + (size_t)w * 2 * FF * DM, P.norm_g + (l * 3 + (j ? 2 : 0)) * DM, true, scr, r, lane); }
    else if (id < 8) { const int w = id - 4; p0_item(P.ffn_w_out + (size_t)w * FF * DM, FF, DM, (bf16*)(ws + WS_WFOUT) + (size_t)w * DM * FF, nullptr, false, scr, r, lane); }
    else if (id == 8) p0_item(P.attn_w_in, DM, AIN, (bf16*)(ws + WS_WAIN), P.norm_g + (0 * 3 + 1) * DM, false, scr, r, lane);
    else if (id == 9) p0_item(P.attn_w_out, DM, DM, (bf16*)(ws + WS_WAOUT), nullptr, false, scr, r, lane);
    else if (id == 10) p0_item(P.rec_w_in, DM, RIN, (bf16*)(ws + WS_WRIN), P.norm_g + (1 * 3 + 1) * DM, false, scr, r, lane);
    else p0_item(P.rec_w_out, DM, DM, (bf16*)(ws + WS_WROUT), nullptr, false, scr, r, lane);
}
template <int A, int B, int C> __device__ __forceinline__ void convert_stage(const Ptrs& P, LAS unsigned char* lds, int wave, int lane, int gwi, int ngw) {
    LAS float* scr = (LAS float*)(lds + RING_OFF + wave * 16384);
    constexpr int nA = conv_items_of(A), nB = conv_items_of(B), nC = conv_items_of(C);
    for (int it = gwi; it < nA + nB + nC; it += ngw) {
        if (it < nA) conv_item(P, A, it, scr, lane);
        else if (it < nA + nB) conv_item(P, B, it - nA, scr, lane);
        else conv_item(P, C, it - nA - nB, scr, lane);
    }
}
template <int A, int B, int C> __device__ __forceinline__ void convert_in_slack(const Ptrs& P, LAS unsigned char* lds, int wave, int lane, int nwg) {
    const int G = gridDim.x, rem = nwg % G, c = blockIdx.x;
    if (rem == 0) { convert_stage<A, B, C>(P, lds, wave, lane, c * NWAVES + wave, G * NWAVES); __syncthreads(); }
    else if (c >= rem) { convert_stage<A, B, C>(P, lds, wave, lane, (c - rem) * NWAVES + wave, (G - rem) * NWAVES); __syncthreads(); }
}

__device__ __forceinline__ void p0_prologue(const Ptrs& P, LAS unsigned char* lds, int wave, int lane) {
    const int gw = blockIdx.x * NWAVES + wave, NGW = gridDim.x * NWAVES;
    unsigned char* ws = P.ws;
    convert_stage<0, -1, -1>(P, lds, wave, lane, gw, NGW);
    bf16* hb = (bf16*)(ws + WS_HB); float* part = (float*)(ws + WS_PART);
    for (int m = gw; m < M; m += NGW) {
        const GAS f32x4* xr = (const GAS f32x4*)(P.x + (size_t)m * DM) + lane;
        f32x4 v[4]; float s = 0.f;
#pragma unroll
        for (int j = 0; j < 4; ++j) { v[j] = xr[64 * j]; s += (v[j].x * v[j].x + v[j].y * v[j].y) + (v[j].z * v[j].z + v[j].w * v[j].w); }
        s = wave_sum(s);
        GAS unsigned long long* o8 = (GAS unsigned long long*)(hb + (size_t)m * DM) + lane;
#pragma unroll
        for (int j = 0; j < 4; ++j) o8[64 * j] = (unsigned long long)pk2(v[j].x, v[j].y) | ((unsigned long long)pk2(v[j].z, v[j].w) << 32);
        if (lane < 16) part[(size_t)m * 16 + lane] = lane == 0 ? s : 0.f;
    }
}

__device__ __forceinline__ void final_norm(const Ptrs& P, int wave, int lane) {
    const int gw = blockIdx.x * NWAVES + wave, NGW = gridDim.x * NWAVES;
    const bf16* hb = (const bf16*)(P.ws + WS_HB);
    f32x4 g[4];
#pragma unroll
    for (int j = 0; j < 4; ++j) g[j] = ((const f32x4*)P.final_g)[2 * lane + (j & 1) + 128 * (j >> 1)];
    for (int m = gw; m < M; m += NGW) {
        const v4u* hr = (const v4u*)(hb + (size_t)m * DM) + lane;
        f32x4 v[4]; float s = 0.f;
#pragma unroll
        for (int jj = 0; jj < 2; ++jj) { const v4u w = hr[64 * jj]; v[2 * jj] = pg8::bf2x_lo(w.x, w.y); v[2 * jj + 1] = pg8::bf2x_lo(w.z, w.w); }
#pragma unroll
        for (int j = 0; j < 4; ++j) s += (v[j].x * v[j].x + v[j].y * v[j].y) + (v[j].z * v[j].z + v[j].w * v[j].w);
        const float r = 1.0f / sqrtf(wave_sum(s) * (1.0f / DM) + pg8::RMS_EPS);
        GAS f32x4* orow = (GAS f32x4*)(P.out + (size_t)m * DM);
#pragma unroll
        for (int j = 0; j < 4; ++j) orow[2 * lane + (j & 1) + 128 * (j >> 1)] = v[j] * r * g[j];
    }
}

constexpr int VSTR = 80;
constexpr int VT_BYTES = 64 * VSTR;
constexpr int OTSTR = 144;
__device__ __forceinline__ void load_v(const bf16* vsrc, int pitch, int lane, bf16x8 (&v)[4]) {
#pragma unroll
    for (int i = 0; i < 4; ++i) v[i] = *(const bf16x8*)(vsrc + (size_t)(i * 8 + (lane >> 3)) * pitch + 8 * (lane & 7));
}
__device__ __forceinline__ void stage_vt(LAS unsigned char* vt, int lane, const bf16x8 (&v)[4]) {
#pragma unroll
    for (int i = 0; i < 4; ++i) { const int kk = i * 8 + (lane >> 3), p = (kk & 16) | swap23(kk & 15), c = lane & 7;
#pragma unroll
        for (int j = 0; j < 8; ++j) *(LAS short*)(vt + (8 * c + j) * VSTR + 2 * p) = v[i][j]; }
}
__device__ __forceinline__ bf16x8 read_vt(const LAS unsigned char* vt, int d, int s2, int h) { return *(const LAS bf16x8*)(vt + d * VSTR + 32 * s2 + 16 * h); }
__device__ __forceinline__ void load_k(const bf16* kp, bf16x8 (&k)[4]) {
#pragma unroll
    for (int st = 0; st < 4; ++st) k[st] = *(const bf16x8*)(kp + 16 * st);
}
__device__ __forceinline__ void store_o(LAS unsigned char* ot, bf16* op  , const f32x16& O0, const f32x16& O1, int lane) {
    const int c = lane & 31, hi = lane >> 5;
#pragma unroll
    for (int r = 0; r < 16; ++r) { LAS unsigned char* p = ot + crow(r, hi) * OTSTR + 2 * c; *(LAS unsigned short*)p = (unsigned short)f2bf(O0[r]); *(LAS unsigned short*)(p + 64) = (unsigned short)f2bf(O1[r]); }
#pragma unroll
    for (int i = 0; i < 4; ++i) { const int row = i * 8 + (lane >> 3), ch = lane & 7; *(bf16x8*)(op + (size_t)row * DM + 8 * ch) = *(const LAS bf16x8*)(ot + row * OTSTR + 16 * ch); }
}

__device__ __forceinline__ void swa_unit(const bf16* qkv, bf16* obuf, const float* sinks, int b, int hq, int qb, LAS unsigned char* vt, int lane) {
    const int c = lane & 31, hi = lane >> 5, kvh = hq >> 2;
    const size_t rowbase = (size_t)b * SEQ;
    const bf16* qp = qkv + (rowbase + qb * 32 + c) * AIN + hq * 64 + 8 * hi;
    bf16x8 qf[4]; load_k(qp, qf);
    bf16x8 kf[5][4];
#pragma unroll
    for (int i = 0; i < 5; ++i) { const int kb = qb - 4 + i; if (kb >= 0) load_k(qkv + (rowbase + kb * 32 + c) * AIN + 512 + kvh * 64 + 8 * hi, kf[i]); }
    const bf16* vbase = qkv + rowbase * AIN + 640 + kvh * 64;
    const int i0 = qb >= 4 ? 0 : 4 - qb;
    bf16x8 vcur[4], vnext[4];
    load_v(vbase + (size_t)(qb - 4 + i0) * 32 * AIN, AIN, lane, vcur);
    const float slope = exp2f(-(float)(hq + 1)), sink = sinks[hq];
    f32x16 X[5]; float mx = -INFINITY;
#pragma unroll
    for (int i = 0; i < 5; ++i) { const int kb = qb - 4 + i;
        f32x16 a;
#pragma unroll
        for (int r = 0; r < 16; ++r) a[r] = 0.f;
        if (kb >= 0) {
#pragma unroll
            for (int st = 0; st < 4; ++st) a = MFMA32(kf[i][st], qf[st], a);
#pragma unroll
            for (int r = 0; r < 16; ++r) { const int dist = (qb * 32 + c) - (kb * 32 + crow(r, hi)); const bool valid = dist >= 0 && dist < 128;
                const float s = valid ? a[r] * 0.125f - slope * (float)dist : -INFINITY; a[r] = s; mx = fmaxf(mx, s); }
        } else {
#pragma unroll
            for (int r = 0; r < 16; ++r) a[r] = -INFINITY;
        }
        X[i] = a; }
    mx = fmaxf(mx, __shfl_xor(mx, 32)); mx = fmaxf(mx, sink);
    float sum = 0.f;
#pragma unroll
    for (int i = 0; i < 5; ++i)
#pragma unroll
        for (int r = 0; r < 16; ++r) { const float p = __expf(X[i][r] - mx); X[i][r] = p; sum += p; }
    sum += __shfl_xor(sum, 32);
    const float inv = 1.0f / (sum + __expf(sink - mx));
    f32x16 O0, O1;
#pragma unroll
    for (int r = 0; r < 16; ++r) { O0[r] = 0.f; O1[r] = 0.f; }
#pragma unroll
    for (int i = 0; i < 5; ++i) { const int kb = qb - 4 + i;
        if (kb >= 0) {
            if (i < 4) load_v(vbase + (size_t)(kb + 1) * 32 * AIN, AIN, lane, vnext);
            stage_vt(vt, lane, vcur);
#pragma unroll
            for (int s2 = 0; s2 < 2; ++s2) {
                const bf16x8 pf = packf8(X[i][8 * s2 + 0] * inv, X[i][8 * s2 + 1] * inv, X[i][8 * s2 + 2] * inv, X[i][8 * s2 + 3] * inv, X[i][8 * s2 + 4] * inv, X[i][8 * s2 + 5] * inv, X[i][8 * s2 + 6] * inv, X[i][8 * s2 + 7] * inv);
                O0 = MFMA32(pf, read_vt(vt, c, s2, hi), O0); O1 = MFMA32(pf, read_vt(vt, c + 32, s2, hi), O1); }
            if (i < 4) {
#pragma unroll
                for (int k = 0; k < 4; ++k) vcur[k] = vnext[k]; }
        } }
    store_o(vt + VT_BYTES, obuf + (rowbase + qb * 32) * DM + hq * 64, O0, O1, lane);
}

__device__ __forceinline__ void sb_unit(const bf16* qkv, bf16* obuf, int b, int h, int qb, LAS unsigned char* vt, int lane) {
    const int c = lane & 31, hi = lane >> 5, t = qb * 32 + c;
    const size_t rowbase = (size_t)b * SEQ;
    bf16x8 qf[4]; load_k(qkv + (rowbase + t) * AIN + 768 + h * 64 + 8 * hi, qf);
    const bf16* kbase = qkv + (rowbase + c) * AIN + 1280 + h * 64 + 8 * hi;
    const bf16* vbase = qkv + rowbase * AIN + 1792 + h * 64;
    bf16x8 kf[4], vf[4], kn[4], vn[4];
    load_k(kbase + (size_t)qb * 32 * AIN, kf); load_v(vbase + (size_t)qb * 32 * AIN, AIN, lane, vf);
    float carry = 0.f;
    f32x16 O0, O1;
#pragma unroll
    for (int r = 0; r < 16; ++r) { O0[r] = 0.f; O1[r] = 0.f; }
    for (int kb = qb; kb >= 0; --kb) {
        { const int kbn = kb > 0 ? kb - 1 : 0; load_k(kbase + (size_t)kbn * 32 * AIN, kn); load_v(vbase + (size_t)kbn * 32 * AIN, AIN, lane, vn); }
        f32x16 a;
#pragma unroll
        for (int r = 0; r < 16; ++r) a[r] = 0.f;
#pragma unroll
        for (int st = 0; st < 4; ++st) a = MFMA32(kf[st], qf[st], a);
        float lk[16], lsg[16];
#pragma unroll
        for (int r = 0; r < 16; ++r) { const float z = a[r] * 0.125f; const bool causal = (kb * 32 + crow(r, hi)) < t;
            const float sp = fmaxf(z, 0.f) + __logf(1.0f + __expf(-fabsf(z)));
            lk[r] = causal ? -sp : 0.f; lsg[r] = z - sp; }
        float G[4], Gp[4];
#pragma unroll
        for (int g = 0; g < 4; ++g) { G[g] = (lk[4 * g] + lk[4 * g + 1]) + (lk[4 * g + 2] + lk[4 * g + 3]); Gp[g] = __shfl_xor(G[g], 32); }
        float tail = 0.f; f32x16 w;
#pragma unroll
        for (int g = 3; g >= 0; --g) { const float base = carry + tail + (hi == 0 ? Gp[g] : 0.f); float run = 0.f;
#pragma unroll
            for (int i = 3; i >= 0; --i) { const int r = 4 * g + i; const bool causal = (kb * 32 + crow(r, hi)) < t;
                w[r] = causal ? __expf(lsg[r] + base + run) : 0.f; run += lk[r]; }
            tail += G[g] + Gp[g]; }
        carry += tail;
        stage_vt(vt, lane, vf);
#pragma unroll
        for (int s2 = 0; s2 < 2; ++s2) {
            const bf16x8 pf = packf8(w[8 * s2 + 0], w[8 * s2 + 1], w[8 * s2 + 2], w[8 * s2 + 3], w[8 * s2 + 4], w[8 * s2 + 5], w[8 * s2 + 6], w[8 * s2 + 7]);
            O0 = MFMA32(pf, read_vt(vt, c, s2, hi), O0); O1 = MFMA32(pf, read_vt(vt, c + 32, s2, hi), O1); }
        if (__all(carry < SB_EXIT)) break;
#pragma unroll
        for (int k = 0; k < 4; ++k) { kf[k] = kn[k]; vf[k] = vn[k]; }
    }
    store_o(vt + VT_BYTES, obuf + (rowbase + qb * 32) * DM + 512 + h * 64, O0, O1, lane);
}

__device__ __forceinline__ void attn_phase(const Ptrs& P, LAS unsigned char* lds, int wave, int lane) {
    const bf16* qkv = (const bf16*)(P.ws + WS_ACT); bf16* obuf = (bf16*)(P.ws + WS_OB);
    LAS unsigned char* vt = lds + RING_OFF + wave * 10240;
    const int gw = blockIdx.x * NWAVES + wave, NGW = gridDim.x * NWAVES;
    constexpr int NU = BATCH * 8 * (SEQ / 32);
    for (int u = gw; u < 2 * NU; u += NGW) {
        if (u < NU) { const int qb = (SEQ / 32 - 1) - (u >> 6), bh = u & 63; sb_unit(qkv, obuf, bh >> 3, bh & 7, qb, vt, lane); }
        else { const int v = u - NU, qb = v >> 6, bh = v & 63; swa_unit(qkv, obuf, P.attn_sinks, bh >> 3, bh & 7, qb, vt, lane); }
    }
}

constexpr int KSTR = 144;
constexpr int QSTR = 272;
constexpr int OSTR = 132;
constexpr int L_TOT = 0, L_GL = 2048, L_KS = L_GL + 64 * OSTR * 4, L_VT = L_KS + 128 * KSTR, L_RZ = L_VT + 128 * KSTR, L_RV = L_RZ + 64 * QSTR, L_A_END = L_RV + 64 * QSTR;
constexpr int L_QI = L_KS, L_QX = L_QI + 64 * QSTR, L_KX = L_QX + 64 * QSTR, L_VT2 = L_KX + 64 * QSTR, L_OF = L_GL, L_RS = L_VT2 + 128 * KSTR, L_C_END = L_RS + 256;
static_assert(L_A_END <= RING_BYTES && L_C_END <= RING_BYTES, "HGRN2 LDS map");

__device__ __forceinline__ float hgrn_lb(const float* logits, int col) {
    const float l0 = logits[col], l1 = logits[512 + col]; return 1.0f / (1.0f + __expf(l0 - l1));
}
__device__ __forceinline__ void tile_load(const bf16* src, int tid, bf16x8 (&r)[2]) {
#pragma unroll
    for (int i = 0; i < 2; ++i) { const int ci = tid + 512 * i; r[i] = *(const bf16x8*)(src + (size_t)(ci >> 4) * RIN + 8 * (ci & 15)); }
}
__device__ __forceinline__ void tile_to_lds(LAS unsigned char* dst, int tid, const bf16x8 (&r)[2]) {
#pragma unroll
    for (int i = 0; i < 2; ++i) { const int ci = tid + 512 * i; *(LAS bf16x8*)(dst + (ci >> 4) * QSTR + 16 * (ci & 15)) = r[i]; }
}
__device__ __forceinline__ float lds_bf(const LAS unsigned char* img, int t, int d) { return bf2f(*(const LAS unsigned short*)(img + t * QSTR + 2 * d)); }
__device__ __forceinline__ void hgrn_gates(const LAS unsigned char* rz, int d, int tq, float lbv, LAS float* tot, LAS float* GL) {
    float cum = 0.f;
#pragma unroll
    for (int j = 0; j < 16; ++j) { const float z = lds_bf(rz, tq * 16 + j, d);
        const float sg = 1.0f / (1.0f + __expf(-z)); cum += __logf(lbv + (1.0f - lbv) * sg); GL[(tq * 16 + j) * 128 + d] = cum; }
    tot[tq * 128 + d] = cum;
    __syncthreads();
}

__device__ __forceinline__ void rec_pass_a(const Ptrs& P, LAS unsigned char* lds, int wave, int lane) {
    const bf16* qkv = (const bf16*)(P.ws + WS_ACT); bf16* obuf = (bf16*)(P.ws + WS_OB);
    float* st = (float*)(P.ws + WS_ST); float* dec = (float*)(P.ws + WS_DEC);
    const int tid = threadIdx.x, d = tid & 127, tq = tid >> 7, c = lane & 31, hi = lane >> 5, G = gridDim.x;
    LAS float* tot = (LAS float*)(lds + L_TOT); LAS float* GL = (LAS float*)(lds + L_GL);
    bf16x8 pz[2], pv[2];
    int u = blockIdx.x;
    if (u < 1024) { const bf16* src = qkv + ((size_t)(u >> 7) * SEQ + (u & 31) * 64) * RIN + ((u >> 5) & 3) * 128; tile_load(src + 512, tid, pz); tile_load(src + 1024, tid, pv); }
    for (; u < 1024; u += G) {
        const int hh = (u >> 5) & 3;
        tile_to_lds(lds + L_RZ, tid, pz); tile_to_lds(lds + L_RV, tid, pv);
        { const int un = u + G; if (un < 1024) { const bf16* src = qkv + ((size_t)(un >> 7) * SEQ + (un & 31) * 64) * RIN + ((un >> 5) & 3) * 128; tile_load(src + 512, tid, pz); tile_load(src + 1024, tid, pv); } }
        __syncthreads();
        const float lbv = hgrn_lb(P.lb_logits, hh * 128 + d);
        hgrn_gates(lds + L_RZ, d, tq, lbv, tot, GL);
        float off = 0.f;
#pragma unroll
        for (int q = 0; q < 3; ++q) off += (q < tq) ? tot[q * 128 + d] : 0.f;
        const float glast = tot[d] + tot[128 + d] + tot[256 + d] + tot[384 + d];
        if (tq == 0) dec[u * 128 + d] = __expf(glast);
#pragma unroll
        for (int grp = 0; grp < 2; ++grp) {
            float ks[8]; bf16x8 vv;
#pragma unroll
            for (int j = 0; j < 8; ++j) { const int t = tq * 16 + grp * 8 + j; const float z = lds_bf(lds + L_RZ, t, d), g = GL[t * 128 + d] + off;
                ks[j] = (1.0f - lbv) / (1.0f + __expf(z)) * __expf(glast - g); vv[j] = *(const LAS short*)(lds + L_RV + t * QSTR + 2 * d); }
            *(LAS bf16x8*)(lds + L_KS + d * KSTR + tq * 32 + grp * 16) = packf8(ks[0], ks[1], ks[2], ks[3], ks[4], ks[5], ks[6], ks[7]);
            *(LAS bf16x8*)(lds + L_VT + d * KSTR + tq * 32 + grp * 16) = vv;
        }
        __syncthreads();
        const int eb = wave >> 1;
#pragma unroll
        for (int dbi = 0; dbi < 2; ++dbi) { const int db = 2 * (wave & 1) + dbi;
            f32x16 acc;
#pragma unroll
            for (int r = 0; r < 16; ++r) acc[r] = 0.f;
#pragma unroll
            for (int s = 0; s < 4; ++s) acc = MFMA32(*(const LAS bf16x8*)(lds + L_VT + (eb * 32 + c) * KSTR + 32 * s + 16 * hi), *(const LAS bf16x8*)(lds + L_KS + (db * 32 + c) * KSTR + 32 * s + 16 * hi), acc);
            float* sp = st + ((size_t)u * 128 + eb * 32) * 128 + db * 32 + c;
#pragma unroll
            for (int r = 0; r < 16; ++r) sp[(size_t)crow(r, hi) * 128] = acc[r]; }
        __syncthreads();
    }
    const int gid = blockIdx.x * (NWAVES * 64) + tid, NT = gridDim.x * NWAVES * 64;
#pragma unroll 2
    for (int it = gid; it < M * 64; it += NT) {
        const int row = it >> 6, c8 = (it & 63) * 8, t = row & (SEQ - 1);
        const bf16* rp = qkv + (size_t)row * RIN; const bf16* rp1 = t >= 1 ? rp - RIN : rp; const bf16* rp2 = t >= 2 ? rp - 2 * RIN : rp;
        const float m1 = t >= 1 ? 1.f : 0.f, m2 = t >= 2 ? 1.f : 0.f;
        const bf16x8 gb = *(const bf16x8*)(rp + 2048 + c8), gc0 = *(const bf16x8*)(rp + 2560 + c8), u0 = *(const bf16x8*)(rp + 3072 + c8);
        const bf16x8 gc1 = *(const bf16x8*)(rp1 + 2560 + c8), u1 = *(const bf16x8*)(rp1 + 3072 + c8), gc2 = *(const bf16x8*)(rp2 + 2560 + c8), u2 = *(const bf16x8*)(rp2 + 3072 + c8);
        const f32x4 w0a = *(const f32x4*)(P.conv_w + c8), w0b = *(const f32x4*)(P.conv_w + c8 + 4), w1a = *(const f32x4*)(P.conv_w + 512 + c8), w1b = *(const f32x4*)(P.conv_w + 512 + c8 + 4), w2a = *(const f32x4*)(P.conv_w + 1024 + c8), w2b = *(const f32x4*)(P.conv_w + 1024 + c8 + 4);
        float o[8];
#pragma unroll
        for (int j = 0; j < 8; ++j) { const float w0 = j < 4 ? w0a[j & 3] : w0b[j & 3], w1 = j < 4 ? w1a[j & 3] : w1b[j & 3], w2 = j < 4 ? w2a[j & 3] : w2b[j & 3];
            const float x0 = bf2f((unsigned short)gc0[j]) * bf2f((unsigned short)u0[j]), x1 = m1 * bf2f((unsigned short)gc1[j]) * bf2f((unsigned short)u1[j]), x2 = m2 * bf2f((unsigned short)gc2[j]) * bf2f((unsigned short)u2[j]);
            o[j] = bf2f((unsigned short)gb[j]) * (w0 * x2 + w1 * x1 + w2 * x0); }
        *(bf16x8*)(obuf + (size_t)row * DM + 512 + c8) = packf8(o[0], o[1], o[2], o[3], o[4], o[5], o[6], o[7]);
    }
}

__device__ __forceinline__ void rec_pass_b(const Ptrs& P) {
    const float* st = (const float*)(P.ws + WS_ST); const float* dec = (const float*)(P.ws + WS_DEC); bf16* sb = (bf16*)(P.ws + WS_SB);
    const int gid = blockIdx.x * (NWAVES * 64) + threadIdx.x, NT = gridDim.x * NWAVES * 64;
    for (int x = gid; x < 32 * 4096; x += NT) {
        const int seq = x >> 12, ed = (x & 4095) * 4, d = ed & 127; f32x4 S = {0.f, 0.f, 0.f, 0.f};
#pragma unroll 1
        for (int half = 0; half < 2; ++half) {
            f32x4 kv[16], dc[16];
#pragma unroll
            for (int i = 0; i < 16; ++i) { const size_t u = (size_t)seq * 32 + half * 16 + i; kv[i] = *(const f32x4*)(st + u * 16384 + ed); dc[i] = *(const f32x4*)(dec + u * 128 + d); }
#pragma unroll
            for (int i = 0; i < 16; ++i) { const size_t u = (size_t)seq * 32 + half * 16 + i;
                u32x2v w; w.x = pg8::cvt_pk_bf16(S[0], S[1]); w.y = pg8::cvt_pk_bf16(S[2], S[3]); *(u32x2v*)(sb + u * 16384 + ed) = w;
                S = dc[i] * S + kv[i]; }
        }
    }
}

__device__ __forceinline__ void rec_pass_c(const Ptrs& P, LAS unsigned char* lds, int wave, int lane) {
    const bf16* qkv = (const bf16*)(P.ws + WS_ACT); bf16* obuf = (bf16*)(P.ws + WS_OB); const bf16* sb = (const bf16*)(P.ws + WS_SB);
    const int tid = threadIdx.x, d = tid & 127, tq = tid >> 7, c = lane & 31, hi = lane >> 5, G = gridDim.x;
    const int tb = wave & 1, eb = wave >> 1;
    LAS float* tot = (LAS float*)(lds + L_TOT); LAS float* GL = (LAS float*)(lds + L_GL); LAS float* OF = (LAS float*)(lds + L_OF); LAS float* RS = (LAS float*)(lds + L_RS);
    bf16x8 pq[2], pz[2], pv[2];
    int u = blockIdx.x;
    if (u < 1024) { const bf16* src = qkv + ((size_t)(u >> 7) * SEQ + (u & 31) * 64) * RIN + ((u >> 5) & 3) * 128; tile_load(src, tid, pq); tile_load(src + 512, tid, pz); tile_load(src + 1024, tid, pv); }
    for (; u < 1024; u += G) {
        const int b = u >> 7, hh = (u >> 5) & 3, ch = u & 31; const size_t row0 = (size_t)b * SEQ + ch * 64;
        tile_to_lds(lds + L_QI, tid, pq); tile_to_lds(lds + L_KX, tid, pz); tile_to_lds(lds + L_QX, tid, pv);
        bf16x8 sf[8], pg[2];
        { const bf16* sp = sb + ((size_t)u * 128 + eb * 32 + c) * 128 + 8 * hi;
#pragma unroll
            for (int s = 0; s < 8; ++s) sf[s] = *(const bf16x8*)(sp + 16 * s); }
        tile_load(qkv + row0 * RIN + 1536 + hh * 128, tid, pg);
        { const int un = u + G; if (un < 1024) { const bf16* src = qkv + ((size_t)(un >> 7) * SEQ + (un & 31) * 64) * RIN + ((un >> 5) & 3) * 128; tile_load(src, tid, pq); tile_load(src + 512, tid, pz); tile_load(src + 1024, tid, pv); } }
        __syncthreads();
        const float lbv = hgrn_lb(P.lb_logits, hh * 128 + d);
        hgrn_gates(lds + L_KX, d, tq, lbv, tot, GL);
        float off = 0.f;
#pragma unroll
        for (int q = 0; q < 3; ++q) off += (q < tq) ? tot[q * 128 + d] : 0.f;
        const float gref = tot[d] + tot[128 + d];
#pragma unroll
        for (int grp = 0; grp < 2; ++grp) { bf16x8 vv;
#pragma unroll
            for (int k = 0; k < 8; ++k) { const int j = (k & 3) + 8 * (k >> 2) + 4 * grp; vv[k] = *(const LAS short*)(lds + L_QX + (tq * 16 + j) * QSTR + 2 * d); }
            *(LAS bf16x8*)(lds + L_VT2 + d * KSTR + tq * 32 + grp * 16) = vv; }
#pragma unroll 4
        for (int j = 0; j < 16; ++j) { const int t = tq * 16 + j;
            const float qv = lds_bf(lds + L_QI, t, d), z = lds_bf(lds + L_KX, t, d), g = GL[t * 128 + d] + off, sq = pg8::silu_f(qv);
            const float kx = (1.0f - lbv) / (1.0f + __expf(z)) * __expf(fminf(gref - g, 80.f));
            *(LAS unsigned short*)(lds + L_QI + t * QSTR + 2 * d) = (unsigned short)f2bf(sq * __expf(g));
            *(LAS unsigned short*)(lds + L_QX + t * QSTR + 2 * d) = (unsigned short)f2bf(sq * __expf(fminf(g - gref, 80.f)));
            *(LAS unsigned short*)(lds + L_KX + t * QSTR + 2 * d) = (unsigned short)f2bf(kx); }
        __syncthreads();
        f32x16 acc;
#pragma unroll
        for (int r = 0; r < 16; ++r) acc[r] = 0.f;
#pragma unroll
        for (int s = 0; s < 8; ++s) acc = MFMA32(*(const LAS bf16x8*)(lds + L_QI + (tb * 32 + c) * QSTR + 32 * s + 16 * hi), sf[s], acc);
        for (int sbk = 0; sbk <= tb; ++sbk) {
            f32x16 X;
#pragma unroll
            for (int r = 0; r < 16; ++r) X[r] = 0.f;
#pragma unroll
            for (int s = 0; s < 8; ++s) X = MFMA32(*(const LAS bf16x8*)(lds + L_KX + (sbk * 32 + c) * QSTR + 32 * s + 16 * hi), *(const LAS bf16x8*)(lds + L_QX + (tb * 32 + c) * QSTR + 32 * s + 16 * hi), X);
#pragma unroll
            for (int r = 0; r < 16; ++r) X[r] = (sbk * 32 + crow(r, hi) <= tb * 32 + c) ? X[r] : 0.f;
#pragma unroll
            for (int s2 = 0; s2 < 2; ++s2) {
                const bf16x8 pf = packf8(X[8 * s2 + 0], X[8 * s2 + 1], X[8 * s2 + 2], X[8 * s2 + 3], X[8 * s2 + 4], X[8 * s2 + 5], X[8 * s2 + 6], X[8 * s2 + 7]);
                acc = MFMA32(pf, *(const LAS bf16x8*)(lds + L_VT2 + (eb * 32 + c) * KSTR + sbk * 64 + 32 * s2 + 16 * hi), acc); }
        }
#pragma unroll
        for (int r = 0; r < 16; ++r) OF[(tb * 32 + crow(r, hi)) * OSTR + eb * 32 + c] = acc[r];
        __syncthreads();
        { const int t = tid >> 3, pt = tid & 7; float ss = 0.f;
#pragma unroll
            for (int k = 0; k < 16; ++k) { const float v = OF[t * OSTR + pt * 16 + k]; ss += v * v; }
            ss += __shfl_xor(ss, 1); ss += __shfl_xor(ss, 2); ss += __shfl_xor(ss, 4);
            if (pt == 0) RS[t] = 1.0f / sqrtf(ss * (1.0f / 128.0f) + pg8::RMS_EPS); }
        __syncthreads();
#pragma unroll
        for (int i = 0; i < 2; ++i) { const int ci = tid + 512 * i, t = ci >> 4, e8 = 8 * (ci & 15);
            const f32x4 o0 = *(const LAS f32x4*)(OF + t * OSTR + e8), o1 = *(const LAS f32x4*)(OF + t * OSTR + e8 + 4);
            const f32x4 g0 = *(const f32x4*)(P.hgrn_norm_g + e8), g1 = *(const f32x4*)(P.hgrn_norm_g + e8 + 4); const float rs = RS[t];
            float o[8];
#pragma unroll
            for (int k = 0; k < 8; ++k) { const float gate = bf2f((unsigned short)pg[i][k]); o[k] = (k < 4 ? o0[k & 3] * g0[k & 3] : o1[k & 3] * g1[k & 3]) * rs * pg8::silu_f(gate); }
            *(bf16x8*)(obuf + (row0 + t) * DM + hh * 128 + e8) = packf8(o[0], o[1], o[2], o[3], o[4], o[5], o[6], o[7]); }
        __syncthreads();
    }
}

#ifndef STAGGER_TICKS
#define STAGGER_TICKS 800
#endif
__device__ __forceinline__ void stagger_delay(int nwg, int G, int c) {
    const int rem = nwg % G;
    if (rem == 0 || c < rem || STAGGER_TICKS == 0) return;
    const int j = ((c - rem) * 2) / (G - rem);
    const unsigned long long t0 = __builtin_amdgcn_s_memrealtime(), dt = (unsigned long long)(j + 1) * STAGGER_TICKS;
    while (__builtin_amdgcn_s_memrealtime() - t0 < dt) __builtin_amdgcn_s_sleep(32);
}

constexpr int N_PHASES = 18;
struct Args { Ptrs p; int ph_lo, ph_hi; };
__global__ void __launch_bounds__(NWAVES * 64, 2) trunk_fwd(Args args) {
    extern __shared__ __attribute__((aligned(16))) unsigned char lds_raw[];
    LAS unsigned char* lds = (LAS unsigned char*)lds_raw;
    volatile LAS unsigned* MISC = (volatile LAS unsigned*)(lds + MISC_OFF);
    const int tid = threadIdx.x, lane = tid & 63, wave = __builtin_amdgcn_readfirstlane(tid >> 6);
    const Ptrs& P = args.p;
    unsigned char* ws = P.ws;
    gu32* ctl = (gu32*)(ws + WS_CTL);
    for (int u = tid; u < (LDS_BYTES - LDSCTL_OFF) / 4; u += NWAVES * 64) ((LAS unsigned*)(lds + LDSCTL_OFF))[u] = 0u;
    __syncthreads();
    const int lo = args.ph_lo, hi = args.ph_hi;
    XcdBarrier bar; bar.bar = (unsigned*)(ctl + CW_BAR); bar.x = 0; bar.st = nullptr;
    if (hi - lo > 1) bar = xcd_barrier_post((unsigned*)(ctl + CW_BAR), MISC + 8);
#define IN(k) (lo <= (k) && (k) < hi)
#define SEAM(k) do { if (IN(k) && IN((k) + 1)) xcd_barrier(bar); } while (0)
    bf16* hb = (bf16*)(ws + WS_HB); bf16* ob = (bf16*)(ws + WS_OB); bf16* act = (bf16*)(ws + WS_ACT); float* part = (float*)(ws + WS_PART);
    const int G = gridDim.x, bx = blockIdx.x;

#ifndef DUP_MASK
#define DUP_MASK 0u
#endif
#ifndef EXTRA_BARS
#define EXTRA_BARS 0
#endif
#define DUP(k) ((DUP_MASK >> (k)) & 1u)
    if (IN(0)) { if (DUP(0)) { p0_prologue(P, lds, wave, lane); xcd_barrier(bar); } p0_prologue(P, lds, wave, lane); } SEAM(0);
    for (int eb_ = 0; eb_ < EXTRA_BARS; ++eb_) xcd_barrier(bar);
#define WFIN(i) ((const bf16*)(ws + WS_WFIN) + (size_t)(i) * 2 * FF * DM)
#define WFOUT(i) ((const bf16*)(ws + WS_WFOUT) + (size_t)(i) * DM * FF)
#ifndef PROBE_EPI
#define PROBE_EPI 0
#endif
#define PH_FFN_IN(k, wi, CA, CB, CC) do { if (IN(k)) { if (DUP(k)) { pg8::Gemm g{hb, WFIN(wi), M, 2 * FF, DM}; pg8::StaticOrder S; S.init(M, 2 * FF, G, bx); \
        pg8::EpiSwigluT<PROBE_EPI> E{act, FF, part}; pg8::gemm_phase<pg8::EpiSwigluT<PROBE_EPI>, pg8::StaticOrder, true, true>(lds + RING_OFF, g, S, E); xcd_barrier(bar); } \
        convert_in_slack<CA, CB, CC>(P, lds, wave, lane, (M / 256) * (2 * FF / 256)); \
        pg8::Gemm g{hb, WFIN(wi), M, 2 * FF, DM}; pg8::StaticOrder S; S.init(M, 2 * FF, G, bx); \
        pg8::EpiSwiglu E{act, FF, part}; pg8::gemm_phase<pg8::EpiSwiglu, pg8::StaticOrder, true, true>(lds + RING_OFF, g, S, E); } SEAM(k); } while (0)
#define PH_FFN_OUT_(k, wi, obp, partp) do { pg8::Gemm g{act, WFOUT(wi), M, DM, FF}; pg8::StaticOrder S; S.init(M, DM, G, bx); \
        pg8::EpiResid E{hb, obp, partp, 0.5f}; pg8::gemm_phase<pg8::EpiResid, pg8::StaticOrder, true, true>(lds + RING_OFF, g, S, E); } while (0)
#define PH_FFN_OUT(k, wi) do { if (IN(k)) { if (DUP(k)) { PH_FFN_OUT_(k, wi, ob, (float*)(ws + WS_END)); xcd_barrier(bar); } PH_FFN_OUT_(k, wi, hb, part); } SEAM(k); } while (0)
#define PH_MIX_IN(k, woff, NN, CA, CB, CC) do { if (IN(k)) for (int rep_ = DUP(k) ? 2 : 1; rep_ > 0; --rep_) { if (rep_ == 1 && DUP(k)) xcd_barrier(bar); if (rep_ == 1) convert_in_slack<CA, CB, CC>(P, lds, wave, lane, (M / 256) * ((NN) / 256)); pg8::Gemm g{hb, (const bf16*)(ws + (woff)), M, NN, DM}; pg8::StaticOrder S; S.init(M, NN, G, bx); \
        pg8::EpiRowScale E{act, NN, part}; pg8::gemm_phase<pg8::EpiRowScale, pg8::StaticOrder, true, true>(lds + RING_OFF, g, S, E); } SEAM(k); } while (0)
#define PH_MIX_OUT_(k, woff, obp, partp) do { pg8::Gemm g{ob, (const bf16*)(ws + (woff)), M, DM, DM}; pg8::StaticOrder S; S.init(M, DM, G, bx); \
        pg8::EpiResid E{hb, obp, partp, 1.0f}; pg8::gemm_phase<pg8::EpiResid, pg8::StaticOrder, true, true>(lds + RING_OFF, g, S, E); } while (0)
#define PH_MIX_OUT(k, woff) do { if (IN(k)) { if (DUP(k)) { PH_MIX_OUT_(k, woff, act, (float*)(ws + WS_END)); xcd_barrier(bar); } PH_MIX_OUT_(k, woff, hb, part); } SEAM(k); } while (0)
    PH_FFN_IN(1, 0, 4, 8, 9); PH_FFN_OUT(2, 0);
    PH_MIX_IN(3, WS_WAIN, AIN, 1, 5, -1);
    if (IN(4)) { if (DUP(4)) { attn_phase(P, lds, wave, lane); xcd_barrier(bar); } attn_phase(P, lds, wave, lane); } SEAM(4);
    PH_MIX_OUT(5, WS_WAOUT);
    PH_FFN_IN(6, 1, 2, -1, -1); PH_FFN_OUT(7, 1);
    PH_FFN_IN(8, 2, 6, 10, 11); PH_FFN_OUT(9, 2);
    PH_MIX_IN(10, WS_WRIN, RIN, 3, 7, -1);
    if (IN(11)) { if (DUP(11)) { rec_pass_a(P, lds, wave, lane); xcd_barrier(bar); } rec_pass_a(P, lds, wave, lane); } SEAM(11);
    if (IN(12)) { if (DUP(12)) { rec_pass_b(P); xcd_barrier(bar); } rec_pass_b(P); } SEAM(12);
    if (IN(13)) { if (DUP(13)) { rec_pass_c(P, lds, wave, lane); xcd_barrier(bar); } rec_pass_c(P, lds, wave, lane); } SEAM(13);
    PH_MIX_OUT(14, WS_WROUT);
    PH_FFN_IN(15, 3, -1, -1, -1); PH_FFN_OUT(16, 3);
    if (IN(N_PHASES - 1)) final_norm(P, wave, lane);
#undef IN
#undef SEAM
}

#ifndef MK_PER_PHASE
#define MK_PER_PHASE 0
#endif
extern "C" void kernel_launch(void* const* d_in, const int* in_sizes, int n_in, void* d_out, int out_size, void* d_ws, size_t ws_size, hipStream_t stream) {
    static int grid = 0;
    if (grid == 0) {
        if (n_in != 13 || in_sizes[0] != M * DM || out_size != M * DM || ws_size < WS_END + MiB) { fprintf(stderr, "kernel_launch: unexpected shapes (n_in %d, in0 %d, out %d, ws %zu); nothing launched\n", n_in, n_in > 0 ? in_sizes[0] : -1, out_size, ws_size); grid = -1; return; }
        int dev = 0, cus = 0, per_cu = 0;
        if (hipGetDevice(&dev) != hipSuccess || hipDeviceGetAttribute(&cus, hipDeviceAttributeMultiprocessorCount, dev) != hipSuccess) { grid = -1; return; }
        if (hipFuncSetAttribute((const void*)trunk_fwd, hipFuncAttributeMaxDynamicSharedMemorySize, LDS_BYTES) != hipSuccess) { fprintf(stderr, "kernel_launch: hipFuncSetAttribute failed\n"); grid = -1; return; }
        if (hipOccupancyMaxActiveBlocksPerMultiprocessor(&per_cu, (const void*)trunk_fwd, NWAVES * 64, LDS_BYTES) != hipSuccess || per_cu < 1) { fprintf(stderr, "kernel_launch: occupancy query says %d blocks per CU\n", per_cu); per_cu = 1; }
        (void)hipGetLastError();
        grid = cus;
    }
    if (grid < 0) return;
    (void)hipMemsetAsync((char*)d_ws + WS_CTL, 0, CTL_ZERO_BYTES, stream);
    Args a{};
    const float** pp = (const float**)&a.p;
    for (int i = 0; i < 13; ++i) pp[i] = (const float*)d_in[i];
    a.p.out = (float*)d_out; a.p.ws = (unsigned char*)d_ws;
#if MK_PER_PHASE
    for (int k = 0; k < N_PHASES; ++k) { a.ph_lo = k; a.ph_hi = k + 1; hipLaunchKernelGGL(trunk_fwd, dim3(grid), dim3(NWAVES * 64), LDS_BYTES, stream, a); }
#else
    a.ph_lo = 0; a.ph_hi = N_PHASES; hipLaunchKernelGGL(trunk_fwd, dim3(grid), dim3(NWAVES * 64), LDS_BYTES, stream, a);
#endif
}
```

```cpp
#include <hip/hip_runtime.h>
#include <cstdio>
#include <cstdint>
namespace pg8 {
#define PG8_LAS __attribute__((address_space(3)))
typedef unsigned short bf16_t;
typedef short bf16x8 __attribute__((ext_vector_type(8)));
typedef float f32x4 __attribute__((ext_vector_type(4)));
typedef unsigned u32x4 __attribute__((ext_vector_type(4)));
constexpr int BM = 256, BK = 64, HALF = 128, HTB = HALF * BK * 2  , STAGE_BYTES = 8 * HTB, NXCD = 8, WGM = 8;

__host__ __device__ __forceinline__ int lds_byte(int r, int c) { const int st = (r >> 4) * 2 + (c >> 5), rr = r & 15, cc = c & 31, ob = rr * 64 + cc * 2; return st * 1024 + (ob ^ (((ob >> 9) & 1) << 5)); }
__host__ __device__ __forceinline__ void stage_rc(int b, int& R, int& C) { const int st = b / 1024, sb = b % 1024, swz = sb ^ (((sb >> 9) & 1) << 5); R = (st >> 1) * 16 + swz / 64; C = (st & 1) * 32 + (swz % 64) / 2; }
__host__ __device__ __forceinline__ int perm32(int rho) { const int n = rho >> 4, i = rho & 15; return 8 * (i >> 2) + 4 * n + (i & 3); }

struct Unit { int pm, pn; };
struct Gemm { const bf16_t* A; const bf16_t* Bt; int M, N, K; };

struct StaticOrder {
    int nM, nN, nwg, G, c;
    __host__ __device__ void init(int M, int N, int G_, int c_) { nM = M / BM; nN = N / BM; nwg = nM * nN; G = G_; c = c_; }
    __host__ __device__ bool next(int i, Unit& u) const {
        const long L = (long)i * G + c; if (L >= nwg) return false;
        int wgid = (int)L; { const int q = nwg / NXCD, r = nwg % NXCD, xcd = wgid % NXCD, off = wgid / NXCD; wgid = (xcd < r ? xcd * (q + 1) : r * (q + 1) + (xcd - r) * q) + off; }
        const int nig = WGM * nN, gid = wgid / nig, fm = gid * WGM, gsz = (nM - fm) < WGM ? (nM - fm) : WGM;
        u.pm = fm + ((wgid % nig) % gsz); u.pn = (wgid % nig) / gsz; return true;
    }
    __device__ __forceinline__ void a_ready(const Unit&) const {}
    __device__ __forceinline__ void done(const Unit&) const {}
};
typedef float f32x2_t __attribute__((ext_vector_type(2))); typedef __bf16 bf16x2_t __attribute__((ext_vector_type(2)));
__device__ __forceinline__ unsigned cvt_pk_bf16(float lo, float hi) { f32x2_t v = {lo, hi}; bf16x2_t b = __builtin_convertvector(v, bf16x2_t); return __builtin_bit_cast(unsigned, b); }
__device__ __forceinline__ u32x4 pack8(const f32x4 a, const f32x4 b) { u32x4 w; w.x = cvt_pk_bf16(a[0], a[1]); w.y = cvt_pk_bf16(a[2], a[3]); w.z = cvt_pk_bf16(b[0], b[1]); w.w = cvt_pk_bf16(b[2], b[3]); return w; }
constexpr float RMS_EPS = 1e-6f;
__device__ __forceinline__ float row_rstd(const float* part, int row, int fq) {
    const f32x4 p = *(const f32x4*)(part + (size_t)row * 16 + fq * 4);
    float s = (p[0] + p[1]) + (p[2] + p[3]);
    s += __shfl_xor(s, 16); s += __shfl_xor(s, 32);
    return 1.0f / sqrtf(s * (1.0f / 1024.0f) + RMS_EPS);
}
__device__ __forceinline__ float silu_f(float x) { return x * __builtin_amdgcn_rcpf(1.0f + __expf(-x)); }
struct EpiRowScale {
    static constexpr bool PERM = true, AFTER_DRAIN = false;
    bf16_t* O; int ldc; const float* part;
    __device__ __forceinline__ void operator()(const f32x4 (&acc)[2][2][4][2], const Unit& u, int wr, int wc, int fr, int fq) const {
        const int row0 = u.pm * BM + wr * 64 + fr, col0 = u.pn * BM + wc * 32 + 8 * fq;
#pragma unroll
        for (int ai = 0; ai < 2; ++ai)
#pragma unroll
            for (int m = 0; m < 4; ++m) { const int row = row0 + ai * HALF + m * 16; const float r = row_rstd(part, row, fq);
                bf16_t* rowp = O + (size_t)row * ldc + col0;
#pragma unroll
                for (int bj = 0; bj < 2; ++bj) *(u32x4*)(rowp + bj * HALF) = pack8(acc[ai][bj][m][0] * r, acc[ai][bj][m][1] * r);
                asm volatile("" ::: "memory"); }
    }
};
template <int MODE = 0  > struct EpiSwigluT {
    static constexpr bool PERM = true, AFTER_DRAIN = false;
    bf16_t* O; int ldc; const float* part;
    __device__ __forceinline__ void operator()(const f32x4 (&acc)[2][2][4][2], const Unit& u, int wr, int wc, int fr, int fq) const {
        const int row0 = u.pm * BM + wr * 64 + fr, col0 = u.pn * HALF + wc * 32 + 8 * fq;
        if (MODE == 2) {
#pragma unroll
            for (int ai = 0; ai < 2; ++ai)
#pragma unroll
                for (int bj = 0; bj < 2; ++bj)
#pragma unroll
                    for (int m = 0; m < 4; ++m)
#pragma unroll
                        for (int n = 0; n < 2; ++n) asm volatile("" :: "v"(acc[ai][bj][m][n]));
            return; }
#pragma unroll
        for (int ai = 0; ai < 2; ++ai)
#pragma unroll
            for (int m = 0; m < 4; ++m) { const int row = row0 + ai * HALF + m * 16; const float r = row_rstd(part, row, fq);
                f32x4 o[2];
#pragma unroll
                for (int n = 0; n < 2; ++n) { const f32x4 g = acc[ai][0][m][n] * r, up = acc[ai][1][m][n] * r;
#pragma unroll
                    for (int i = 0; i < 4; ++i) o[n][i] = silu_f(g[i]) * up[i]; }
                const u32x4 pk = pack8(o[0], o[1]);
                if (MODE == 1) asm volatile("" :: "v"(pk)); else *(u32x4*)(O + (size_t)row * ldc + col0) = pk;
                asm volatile("" ::: "memory"); }
    }
};
typedef EpiSwigluT<0> EpiSwiglu;
__device__ __forceinline__ f32x4 bf2x_lo(unsigned a, unsigned b) { f32x4 r; r[0] = __uint_as_float(a << 16); r[1] = __uint_as_float(a & 0xffff0000u); r[2] = __uint_as_float(b << 16); r[3] = __uint_as_float(b & 0xffff0000u); return r; }
struct EpiResid {
    static constexpr bool PERM = true, AFTER_DRAIN = false;
    const bf16_t* base; bf16_t* ob; float* part; float scale;
    __device__ __forceinline__ void operator()(const f32x4 (&acc)[2][2][4][2], const Unit& u, int wr, int wc, int fr, int fq) const {
        const int row0 = u.pm * BM + wr * 64 + fr, col0 = u.pn * BM + wc * 32 + 8 * fq;
#pragma unroll
        for (int ai = 0; ai < 2; ++ai)
#pragma unroll
            for (int m = 0; m < 4; ++m) { const int row = row0 + ai * HALF + m * 16; const size_t off = (size_t)row * 1024 + col0; float ss = 0.f;
#pragma unroll
                for (int bj = 0; bj < 2; ++bj) { const u32x4 bw = *(const u32x4*)(base + off + bj * HALF);
                    const f32x4 h0 = bf2x_lo(bw.x, bw.y) + acc[ai][bj][m][0] * scale, h1 = bf2x_lo(bw.z, bw.w) + acc[ai][bj][m][1] * scale;
                    *(u32x4*)(ob + off + bj * HALF) = pack8(h0, h1);
                    ss += (h0[0] * h0[0] + h0[1] * h0[1]) + (h0[2] * h0[2] + h0[3] * h0[3]) + (h1[0] * h1[0] + h1[1] * h1[1]) + (h1[2] * h1[2] + h1[3] * h1[3]); }
                ss += __shfl_xor(ss, 16); ss += __shfl_xor(ss, 32);
                if (fq == 0) part[(size_t)row * 16 + u.pn * 4 + wc] = ss;
                asm volatile("" ::: "memory"); }
    }
};

template <class Epi, class Sched, bool ALIGN_EPI = false, bool SP2 = false>
__device__ __forceinline__ void gemm_phase(PG8_LAS unsigned char* lds, const Gemm g, const Sched& S, const Epi& E) {
    const int tid = threadIdx.x, wid = __builtin_amdgcn_readfirstlane(tid >> 6), lane = tid & 63, wr = wid >> 2, wc = wid & 3, fr = lane & 15, fq = lane >> 4;
    const int K = g.K, nt = K / BK;
    unsigned voffA[2], voffB[2];
#pragma unroll
    for (int i = 0; i < 2; ++i) { int R, C; stage_rc(tid * 16 + i * 8192, R, C); const int Rb = Epi::PERM ? ((R & ~31) + perm32(R & 31)) : R;
        voffA[i] = (unsigned)(R * K + C) * 2u; voffB[i] = (unsigned)(Rb * K + C) * 2u; }
    const size_t kstep = (size_t)(BK * 2);
    const size_t hstep = (size_t)HALF * K * 2;
    const size_t tstep = 2 * hstep;
    const unsigned ldsw = (unsigned)wid * 1024u;
    const int aoff = lds_byte(wr * 64 + fr, fq * 8), boff = lds_byte(wc * 32 + fr, fq * 8);
#define PG8_SA(b, h) (((b) * 2 + (h)) * HTB)
#define PG8_SB(b, h) ((4 + (b) * 2 + (h)) * HTB)
#define PG8_STAGE(bufoff, gbase, voff) do { _Pragma("unroll") for (int _i = 0; _i < 2; ++_i) \
        __builtin_amdgcn_global_load_lds((const unsigned*)((const char*)(gbase) + (voff)[_i]), (PG8_LAS unsigned*)(lds + (bufoff) + ldsw + _i * 8192), 16, 0, 0); } while (0)
#define PG8_LDA(dst, b, h) do { _Pragma("unroll") for (int m = 0; m < 4; ++m) _Pragma("unroll") for (int k = 0; k < 2; ++k) dst[m][k] = *(const PG8_LAS bf16x8*)(lds + PG8_SA(b, h) + aoff + m * 2048 + k * 1024); } while (0)
#define PG8_LDB(dst, b, h) do { _Pragma("unroll") for (int n = 0; n < 2; ++n) _Pragma("unroll") for (int k = 0; k < 2; ++k) dst[n][k] = *(const PG8_LAS bf16x8*)(lds + PG8_SB(b, h) + boff + n * 2048 + k * 1024); } while (0)
#define PG8_MMA(ai, bj, At, Bt) do { __builtin_amdgcn_s_setprio(1); _Pragma("unroll") for (int m = 0; m < 4; ++m) _Pragma("unroll") for (int n = 0; n < 2; ++n) _Pragma("unroll") for (int k = 0; k < 2; ++k) \
        acc[ai][bj][m][n] = __builtin_amdgcn_mfma_f32_16x16x32_bf16(Bt[n][k], At[m][k], acc[ai][bj][m][n], 0, 0, 0); __builtin_amdgcn_s_setprio(0); } while (0)
#define PG8_WAIT_V(n) asm volatile("s_waitcnt vmcnt(" #n ")" ::: "memory")
#define PG8_WAIT_L(n) asm volatile("s_waitcnt lgkmcnt(" #n ")" ::: "memory")
#define PG8_BAR __builtin_amdgcn_s_barrier()
#define PG8_SCHED __builtin_amdgcn_sched_barrier(0)
    Unit cur, nxt; int ui = 0;
    if (!S.next(0, cur)) return;
    f32x4 acc[2][2][4][2];
#pragma unroll
    for (int a = 0; a < 2; ++a)
#pragma unroll
        for (int b = 0; b < 2; ++b)
#pragma unroll
            for (int m = 0; m < 4; ++m)
#pragma unroll
                for (int n = 0; n < 2; ++n) acc[a][b][m][n] = (f32x4){0.f, 0.f, 0.f, 0.f};
    bf16x8 At[4][2], B0[2][2], B1[2][2];
    const char* cA = (const char*)g.A + (size_t)cur.pm * tstep; const char* cB = (const char*)g.Bt + (size_t)cur.pn * tstep;
    S.a_ready(cur);
    if constexpr (SP2) {
        PG8_STAGE(PG8_SB(0, 0), cB, voffB); PG8_STAGE(PG8_SB(0, 1), cB + hstep, voffB); PG8_STAGE(PG8_SA(0, 0), cA, voffA); PG8_STAGE(PG8_SA(0, 1), cA + hstep, voffA);
        if (wr == 1) PG8_BAR;
        PG8_WAIT_V(2); PG8_BAR;
        PG8_STAGE(PG8_SB(1, 0), cB + kstep, voffB); PG8_STAGE(PG8_SA(1, 0), cA + kstep, voffA); PG8_STAGE(PG8_SB(1, 1), cB + hstep + kstep, voffB);
        PG8_WAIT_V(6); PG8_BAR;
    } else {
        PG8_STAGE(PG8_SB(0, 0), cB, voffB); PG8_STAGE(PG8_SA(0, 0), cA, voffA); PG8_STAGE(PG8_SB(0, 1), cB + hstep, voffB); PG8_STAGE(PG8_SA(0, 1), cA + hstep, voffA);
        if (wr == 1) PG8_BAR;
        PG8_WAIT_V(4); PG8_BAR;
        PG8_STAGE(PG8_SB(1, 0), cB + kstep, voffB); PG8_STAGE(PG8_SA(1, 0), cA + kstep, voffA); PG8_STAGE(PG8_SB(1, 1), cB + hstep + kstep, voffB);
        PG8_WAIT_V(6); PG8_BAR;
    }
    for (;;) {
        const bool has_next = S.next(ui + 1, nxt);
        const char* nA = has_next ? (const char*)g.A + (size_t)nxt.pm * tstep : cA; const char* nB = has_next ? (const char*)g.Bt + (size_t)nxt.pn * tstep : cB;
        for (int t = 0; t < nt; t += 2) {
            const bool last = (t == nt - 2);
            const char* a1 = cA + (size_t)(t + 1) * kstep;
            const char* a2 = last ? nA : cA + (size_t)(t + 2) * kstep; const char* b2 = last ? nB : cB + (size_t)(t + 2) * kstep;
            const char* a3 = a2 + kstep; const char* b3 = b2 + kstep;
            if (last && has_next) S.a_ready(nxt);
            if constexpr (SP2) {
            PG8_LDB(B0, 0, 0); PG8_LDB(B1, 0, 1); PG8_SCHED; PG8_LDA(At, 0, 0); PG8_STAGE(PG8_SA(1, 1), a1 + hstep, voffA);
            PG8_WAIT_V(8); PG8_WAIT_L(0); PG8_BAR; PG8_MMA(0, 0, At, B0); PG8_MMA(0, 1, At, B1); PG8_BAR; PG8_SCHED;
            PG8_LDA(At, 0, 1); PG8_STAGE(PG8_SB(0, 0), b2, voffB); PG8_STAGE(PG8_SB(0, 1), b2 + hstep, voffB); PG8_STAGE(PG8_SA(0, 0), a2, voffA);
            PG8_WAIT_V(8); PG8_WAIT_L(0); PG8_BAR; PG8_MMA(1, 0, At, B0); PG8_MMA(1, 1, At, B1); PG8_BAR; PG8_SCHED;
            PG8_LDB(B0, 1, 0); PG8_LDB(B1, 1, 1); PG8_SCHED; PG8_LDA(At, 1, 0); PG8_STAGE(PG8_SA(0, 1), a2 + hstep, voffA);
            PG8_WAIT_V(8); PG8_WAIT_L(0); PG8_BAR; PG8_MMA(0, 0, At, B0); PG8_MMA(0, 1, At, B1); PG8_BAR; PG8_SCHED;
            PG8_LDA(At, 1, 1); PG8_STAGE(PG8_SB(1, 0), b3, voffB); PG8_STAGE(PG8_SB(1, 1), b3 + hstep, voffB); PG8_STAGE(PG8_SA(1, 0), a3, voffA);
            PG8_WAIT_V(8); PG8_WAIT_L(0); PG8_BAR; PG8_MMA(1, 0, At, B0); PG8_MMA(1, 1, At, B1); PG8_BAR; PG8_SCHED;
            } else {
            PG8_LDB(B0, 0, 0); PG8_SCHED; PG8_LDA(At, 0, 0); PG8_STAGE(PG8_SA(1, 1), a1 + hstep, voffA);
            PG8_WAIT_L(8); PG8_BAR; PG8_WAIT_L(0); PG8_MMA(0, 0, At, B0); PG8_BAR; PG8_SCHED;
            PG8_LDB(B1, 0, 1); PG8_STAGE(PG8_SB(0, 0), b2, voffB);
            PG8_BAR; PG8_WAIT_L(0); PG8_MMA(0, 1, At, B1); PG8_BAR;
            PG8_LDA(At, 0, 1); PG8_STAGE(PG8_SA(0, 0), a2, voffA);
            PG8_BAR; PG8_WAIT_L(0); PG8_MMA(1, 0, At, B0); PG8_BAR; PG8_SCHED;
            PG8_STAGE(PG8_SB(0, 1), b2 + hstep, voffB);
            PG8_WAIT_V(6); PG8_BAR; PG8_MMA(1, 1, At, B1); PG8_BAR;
            PG8_LDB(B0, 1, 0); PG8_SCHED; PG8_LDA(At, 1, 0); PG8_STAGE(PG8_SA(0, 1), a2 + hstep, voffA);
            PG8_WAIT_L(8); PG8_BAR; PG8_WAIT_L(0); PG8_MMA(0, 0, At, B0); PG8_BAR; PG8_SCHED;
            PG8_LDB(B1, 1, 1); PG8_STAGE(PG8_SB(1, 0), b3, voffB);
            PG8_BAR; PG8_WAIT_L(0); PG8_MMA(0, 1, At, B1); PG8_BAR;
            PG8_LDA(At, 1, 1); PG8_STAGE(PG8_SA(1, 0), a3, voffA);
            PG8_BAR; PG8_WAIT_L(0); PG8_MMA(1, 0, At, B0); PG8_BAR; PG8_SCHED;
            PG8_STAGE(PG8_SB(1, 1), b3 + hstep, voffB);
            PG8_WAIT_V(6); PG8_BAR; PG8_MMA(1, 1, At, B1); PG8_BAR;
            }
        }
        if constexpr (ALIGN_EPI) { if (wr == 0) PG8_BAR; }
        if constexpr (!Epi::AFTER_DRAIN) { E(acc, cur, wr, wc, fr, fq); S.done(cur); }
        if (!has_next) break;
#pragma unroll
        for (int a = 0; a < 2; ++a)
#pragma unroll
            for (int b = 0; b < 2; ++b)
#pragma unroll
                for (int m = 0; m < 4; ++m)
#pragma unroll
                    for (int n = 0; n < 2; ++n) acc[a][b][m][n] = (f32x4){0.f, 0.f, 0.f, 0.f};
        cur = nxt; cA = nA; cB = nB; ++ui;
        if constexpr (ALIGN_EPI) { if (wr == 1) PG8_BAR; }
    }
    PG8_WAIT_V(0);
    if constexpr (!ALIGN_EPI) { if (wr == 0) PG8_BAR; }
    PG8_BAR;
    if constexpr (Epi::AFTER_DRAIN) { E.fused(acc, cur, wr, wc, fr, fq, lds, wid, lane); S.done(cur); }
#undef PG8_SA
#undef PG8_SB
#undef PG8_STAGE
#undef PG8_LDA
#undef PG8_LDB
#undef PG8_MMA
#undef PG8_WAIT_V
#undef PG8_WAIT_L
#undef PG8_BAR
#undef PG8_SCHED
}
}

constexpr int NWAVES = 8;
constexpr int BATCH = 8, SEQ = 2048, DM = 1024, FF = 2816, M = BATCH * SEQ;
constexpr int AIN = 2304, RIN = 3584;
constexpr float SB_EXIT = -105.0f;

constexpr size_t MiB = 1u << 20;
constexpr size_t WS_CTL = 0, CTL_ZERO_BYTES = 1 * MiB;
constexpr size_t WS_WFIN = 2 * MiB;
constexpr size_t WS_WFOUT = 46 * MiB;
constexpr size_t WS_WAIN = 68 * MiB, WS_WAOUT = 73 * MiB, WS_WRIN = 75 * MiB, WS_WROUT = 82 * MiB;
constexpr size_t WS_PART = 84 * MiB;
constexpr size_t WS_DEC = 85 * MiB;
constexpr size_t WS_HB = 86 * MiB;
constexpr size_t WS_SB = WS_WFIN;
constexpr size_t WS_OB = 118 * MiB;
constexpr size_t WS_ACT = 150 * MiB;
constexpr size_t WS_ST = 262 * MiB;
constexpr size_t WS_END = 326 * MiB;
constexpr int CW_BAR = 4096;

constexpr int RING_OFF = 0, RING_BYTES = 131072;
constexpr int LDSCTL_OFF = RING_BYTES, MISC_OFF = LDSCTL_OFF + 320;
constexpr int LDS_BYTES = 147456;

#define GAS __attribute__((address_space(1)))
#define LAS __attribute__((address_space(3)))
typedef unsigned short bf16;
typedef unsigned v4u __attribute__((ext_vector_type(4)));
typedef float f32x4 __attribute__((ext_vector_type(4)));
typedef short bf16x8 __attribute__((ext_vector_type(8)));
typedef GAS unsigned gu32;
typedef GAS unsigned long long gu64;
#define RLX_AGENT __ATOMIC_RELAXED, __HIP_MEMORY_SCOPE_AGENT
#define LDS_WAIT() asm volatile("s_waitcnt lgkmcnt(0)" ::: "memory")
#define VM_WAIT() asm volatile("s_waitcnt vmcnt(0)" ::: "memory")
__device__ __forceinline__ unsigned long long rt() { return __builtin_amdgcn_s_memrealtime(); }
__device__ __forceinline__ unsigned f2bf(float f) { unsigned u = __builtin_bit_cast(unsigned, f); return (u + 0x7fffu + ((u >> 16) & 1u)) >> 16; }
__device__ __forceinline__ unsigned pk2(float lo, float hi) { return f2bf(lo) | (f2bf(hi) << 16); }

#define XB_TMO      128
#define XB_XCNT(j)  (256  + 64 * (j))
#define XB_XSUB(j)  (1280 + 64 * (j))
#define XB_XGEN(j)  (2304 + 64 * (j))
#define XB_TOP      3328
#define XB_TOPGEN   3392
#define XCD_BAR_WORDS 3456
#define XB_SPIN_CAP (1u << 18)

__device__ __forceinline__ unsigned xb_ld(unsigned* p)              { return __hip_atomic_load(p, __ATOMIC_RELAXED, __HIP_MEMORY_SCOPE_AGENT); }
__device__ __forceinline__ unsigned xb_add(unsigned* p, unsigned v) { return __hip_atomic_fetch_add(p, v, __ATOMIC_RELAXED, __HIP_MEMORY_SCOPE_AGENT); }
__device__ __forceinline__ unsigned xb_xcc_id() { return (unsigned)__builtin_amdgcn_s_getreg((3 << 11) | 20) & 0xFu; }
#define XB_SPIN(cond, bar) do { unsigned _sp = 0; while (cond) { __builtin_amdgcn_s_sleep(1); \
    if ((++_sp & 255u) == 0u) { if (xb_ld(&(bar)[XB_TMO])) break; if (_sp > XB_SPIN_CAP) { atomicAdd(&(bar)[XB_TMO], 1u); break; } } } } while (0)

struct XcdBarrier {
    unsigned* bar; unsigned x;
    volatile LAS unsigned* st;
};

__device__ __forceinline__ XcdBarrier xcd_barrier_post(unsigned* bar, volatile LAS unsigned* st) {
    XcdBarrier b; b.bar = bar; b.x = xb_xcc_id(); b.st = st;
    if (threadIdx.x == 0) (void)xb_add(&bar[XB_XCNT(b.x)], 1u);
    return b;
}
__device__ __forceinline__ void xcd_barrier_complete(unsigned* bar, unsigned x, unsigned& nloc, unsigned& nx) {
    const unsigned G = gridDim.x * gridDim.y * gridDim.z;
    unsigned sum, cnt, mine, sp = 0u;
    for (;;) {
        sum = 0u; cnt = 0u; mine = 0u;
#pragma unroll
        for (unsigned j = 0; j < 16; ++j) { const unsigned c = xb_ld(&bar[XB_XCNT(j)]); sum += c; cnt += (c > 0u) ? 1u : 0u; mine = (j == x) ? c : mine; }
        if (sum == G) break;
        __builtin_amdgcn_s_sleep(1);
        if ((++sp & 255u) == 0u) { if (xb_ld(&bar[XB_TMO])) break; if (sp > XB_SPIN_CAP) { atomicAdd(&bar[XB_TMO], 1u); break; } }
    }
    nloc = mine > 0u ? mine : 1u; nx = cnt > 0u ? cnt : 1u;
}

__device__ __forceinline__ void xcd_barrier(const XcdBarrier& b) {
    asm volatile("s_waitcnt vmcnt(0)" ::: "memory");
    __syncthreads();
    if (threadIdx.x == 0) {
        unsigned* bar = b.bar;
        __builtin_amdgcn_s_waitcnt(0);
        unsigned nloc = b.st[0], nx = b.st[1];
        if (nloc == 0u) { xcd_barrier_complete(bar, b.x, nloc, nx); b.st[0] = nloc; b.st[1] = nx; }
        const unsigned old = xb_add(&bar[XB_XSUB(b.x)], 1u);
        const unsigned gen = old / nloc;
        if (old + 1u == (gen + 1u) * nloc) {
            __builtin_amdgcn_fence(__ATOMIC_RELEASE, "agent");
            asm volatile("s_waitcnt vmcnt(0)" ::: "memory");
            const unsigned og = xb_add(&bar[XB_TOP], 1u);
            const unsigned tg = og / nx;
            if (og + 1u == (tg + 1u) * nx) xb_add(&bar[XB_TOPGEN], 1u);
            else XB_SPIN(xb_ld(&bar[XB_TOPGEN]) == tg, bar);
            __builtin_amdgcn_fence(__ATOMIC_ACQUIRE, "agent");
            xb_add(&bar[XB_XGEN(b.x)], 1u);
            asm volatile("s_waitcnt vmcnt(0)" ::: "memory");
        } else {
            XB_SPIN(xb_ld(&bar[XB_XGEN(b.x)]) == gen, bar);
            __builtin_amdgcn_fence(__ATOMIC_ACQUIRE, "agent");
            asm volatile("s_waitcnt vmcnt(0)" ::: "memory");
        }
    }
    __syncthreads();
}


typedef float f32x16 __attribute__((ext_vector_type(16)));
typedef unsigned u32x2v __attribute__((ext_vector_type(2)));
__device__ __forceinline__ float bf2f(unsigned short v) { return __uint_as_float((unsigned)v << 16); }
__device__ __forceinline__ int crow(int r, int hi) { return (r & 3) + 8 * (r >> 2) + 4 * hi; }
__device__ __forceinline__ int swap23(int k) { return (k & ~12) | ((k & 4) << 1) | ((k & 8) >> 1); }
#define MFMA32(a, b, c) __builtin_amdgcn_mfma_f32_32x32x16_bf16((a), (b), (c), 0, 0, 0)
__device__ __forceinline__ bf16x8 packf8(float a0, float a1, float a2, float a3, float a4, float a5, float a6, float a7) {
    v4u w; w.x = pg8::cvt_pk_bf16(a0, a1); w.y = pg8::cvt_pk_bf16(a2, a3); w.z = pg8::cvt_pk_bf16(a4, a5); w.w = pg8::cvt_pk_bf16(a6, a7); return __builtin_bit_cast(bf16x8, w); }
__device__ __forceinline__ float wave_sum(float v) {
#pragma unroll
    for (int o = 1; o < 64; o <<= 1) v += __shfl_xor(v, o);
    return v;
}

__device__ __forceinline__ void p0_item(const float* W, int K, int N, bf16* WT, const float* gain, bool swg, LAS float* scr, int item, int lane) {
    const int nblk = N / 32, kb = item / nblk, nb = item % nblk, k0 = 64 * kb, n0 = 32 * nb;
    int sn0 = n0; if (swg) { const int pn = n0 >> 8, bj = (n0 >> 7) & 1, x0 = n0 & 127; sn0 = bj * FF + pn * 128 + x0; }
    const float gl = gain ? gain[k0 + lane] : 1.0f;
    float wv[32];
#pragma unroll
    for (int i = 0; i < 32; ++i) wv[i] = W[(size_t)(k0 + 2 * i + (lane >> 5)) * N + sn0 + (lane & 31)];
#pragma unroll
    for (int i = 0; i < 32; ++i) { const int kk = 2 * i + (lane >> 5); scr[kk * 33 + (lane & 31)] = wv[i] * __shfl(gl, kk); }
    LDS_WAIT(); asm volatile("" ::: "memory");
    const int c = lane & 7;
#pragma unroll
    for (int j = 0; j < 4; ++j) { const int n = (lane >> 3) + 8 * j; const LAS float* s = scr + (8 * c) * 33 + n;
        v4u o; o.x = pk2(s[0 * 33], s[1 * 33]); o.y = pk2(s[2 * 33], s[3 * 33]); o.z = pk2(s[4 * 33], s[5 * 33]); o.w = pk2(s[6 * 33], s[7 * 33]);
        *(GAS v4u*)(WT + (size_t)(n0 + n) * K + k0 + 8 * c) = o; }
    LDS_WAIT(); asm volatile("" ::: "memory");
}

struct Ptrs {
    const float *x, *norm_g, *ffn_w_in, *ffn_w_out, *attn_w_in, *attn_sinks, *attn_w_out, *rec_w_in, *lb_logits, *hgrn_norm_g, *conv_w, *rec_w_out, *final_g;
    float* out; unsigned char* ws;
};

constexpr int I_FIN = (DM / 64) * (2 * FF / 32), I_FOUT = (FF / 64) * (DM / 32), I_AIN = (DM / 64) * (AIN / 32), I_O = (DM / 64) * (DM / 32), I_RIN = (DM / 64) * (RIN / 32);
__host__ __device__ constexpr int conv_items_of(int id) { return id < 0 ? 0 : id < 4 ? I_FIN : id < 8 ? I_FOUT : id == 8 ? I_AIN : id == 10 ? I_RIN : I_O; }
__device__ __forceinline__ void conv_item(const Ptrs& P, int id, int r, LAS float* scr, int lane) {
    unsigned char* ws = P.ws;
    if (id < 4) { const int w = id, l = w >> 1, j = w & 1; p0_item(P.ffn_w_in + (size_t)w * DM * 2 * FF, DM, 2 * FF, (bf16*)(ws + WS_WFIN) + (size_t)w * 2 * FF * DM, P.norm_g + (l * 3 + (j ? 2 : 0)) * DM, true, scr, r, lane); }
    else if (id < 8) { const int w = id - 4; p0_item(P.ffn_w_out + (size_t)w * FF * DM, FF, DM, (bf16*)(ws + WS_WFOUT) + (size_t)w * DM * FF, nullptr, false, scr, r, lane); }
    else if (id == 8) p0_item(P.attn_w_in, DM, AIN, (bf16*)(ws + WS_WAIN), P.norm_g + (0 * 3 + 1) * DM, false, scr, r, lane);
    else if (id == 9) p0_item(P.attn_w_out, DM, DM, (bf16*)(ws + WS_WAOUT), nullptr, false, scr, r, lane);
    else if (id == 10) p0_item(P.rec_w_in, DM, RIN, (bf16*)(ws + WS_WRIN), P.norm_g + (1 * 3 + 1) * DM, false, scr, r, lane);
    else p0_item(P.rec_w_out, DM, DM, (bf16*)(ws + WS_WROUT), nullptr, false, scr, r, lane);
}
template <int A, int B, int C> __device__ __forceinline__ void convert_stage(const Ptrs& P, LAS unsigned char* lds, int wave, int lane, int gwi, int ngw) {
    LAS float* scr = (LAS float*)(lds + RING_OFF + wave * 16384);
    constexpr int nA = conv_items_of(A), nB = conv_items_of(B), nC = conv_items_of(C);
    for (int it = gwi; it < nA + nB + nC; it += ngw) {
        if (it < nA) conv_item(P, A, it, scr, lane);
        else if (it < nA + nB) conv_item(P, B, it - nA, scr, lane);
        else conv_item(P, C, it - nA - nB, scr, lane);
    }
}
template <int A, int B, int C> __device__ __forceinline__ void convert_in_slack(const Ptrs& P, LAS unsigned char* lds, int wave, int lane, int nwg) {
    const int G = gridDim.x, rem = nwg % G, c = blockIdx.x;
    if (rem == 0) { convert_stage<A, B, C>(P, lds, wave, lane, c * NWAVES + wave, G * NWAVES); __syncthreads(); }
    else if (c >= rem) { convert_stage<A, B, C>(P, lds, wave, lane, (c - rem) * NWAVES + wave, (G - rem) * NWAVES); __syncthreads(); }
}

__device__ __forceinline__ void p0_prologue(const Ptrs& P, LAS unsigned char* lds, int wave, int lane) {
    const int gw = blockIdx.x * NWAVES + wave, NGW = gridDim.x * NWAVES;
    unsigned char* ws = P.ws;
    convert_stage<0, -1, -1>(P, lds, wave, lane, gw, NGW);
    bf16* hb = (bf16*)(ws + WS_HB); float* part = (float*)(ws + WS_PART);
    for (int m = gw; m < M; m += NGW) {
        const GAS f32x4* xr = (const GAS f32x4*)(P.x + (size_t)m * DM) + lane;
        f32x4 v[4]; float s = 0.f;
#pragma unroll
        for (int j = 0; j < 4; ++j) { v[j] = xr[64 * j]; s += (v[j].x * v[j].x + v[j].y * v[j].y) + (v[j].z * v[j].z + v[j].w * v[j].w); }
        s = wave_sum(s);
        GAS unsigned long long* o8 = (GAS unsigned long long*)(hb + (size_t)m * DM) + lane;
#pragma unroll
        for (int j = 0; j < 4; ++j) o8[64 * j] = (unsigned long long)pk2(v[j].x, v[j].y) | ((unsigned long long)pk2(v[j].z, v[j].w) << 32);
        if (lane < 16) part[(size_t)m * 16 + lane] = lane == 0 ? s : 0.f;
    }
}

__device__ __forceinline__ void final_norm(const Ptrs& P, int wave, int lane) {
    const int gw = blockIdx.x * NWAVES + wave, NGW = gridDim.x * NWAVES;
    const bf16* hb = (const bf16*)(P.ws + WS_HB);
    f32x4 g[4];
#pragma unroll
    for (int j = 0; j < 4; ++j) g[j] = ((const f32x4*)P.final_g)[2 * lane + (j & 1) + 128 * (j >> 1)];
    for (int m = gw; m < M; m += NGW) {
        const v4u* hr = (const v4u*)(hb + (size_t)m * DM) + lane;
        f32x4 v[4]; float s = 0.f;
#pragma unroll
        for (int jj = 0; jj < 2; ++jj) { const v4u w = hr[64 * jj]; v[2 * jj] = pg8::bf2x_lo(w.x, w.y); v[2 * jj + 1] = pg8::bf2x_lo(w.z, w.w); }
#pragma unroll
        for (int j = 0; j < 4; ++j) s += (v[j].x * v[j].x + v[j].y * v[j].y) + (v[j].z * v[j].z + v[j].w * v[j].w);
        const float r = 1.0f / sqrtf(wave_sum(s) * (1.0f / DM) + pg8::RMS_EPS);
        GAS f32x4* orow = (GAS f32x4*)(P.out + (size_t)m * DM);
#pragma unroll
        for (int j = 0; j < 4; ++j) orow[2 * lane + (j & 1) + 128 * (j >> 1)] = v[j] * r * g[j];
    }
}

constexpr int VSTR = 80;
constexpr int VT_BYTES = 64 * VSTR;
constexpr int OTSTR = 144;
__device__ __forceinline__ void load_v(const bf16* vsrc, int pitch, int lane, bf16x8 (&v)[4]) {
#pragma unroll
    for (int i = 0; i < 4; ++i) v[i] = *(const bf16x8*)(vsrc + (size_t)(i * 8 + (lane >> 3)) * pitch + 8 * (lane & 7));
}
__device__ __forceinline__ void stage_vt(LAS unsigned char* vt, int lane, const bf16x8 (&v)[4]) {
#pragma unroll
    for (int i = 0; i < 4; ++i) { const int kk = i * 8 + (lane >> 3), p = (kk & 16) | swap23(kk & 15), c = lane & 7;
#pragma unroll
        for (int j = 0; j < 8; ++j) *(LAS short*)(vt + (8 * c + j) * VSTR + 2 * p) = v[i][j]; }
}
__device__ __forceinline__ bf16x8 read_vt(const LAS unsigned char* vt, int d, int s2, int h) { return *(const LAS bf16x8*)(vt + d * VSTR + 32 * s2 + 16 * h); }
__device__ __forceinline__ void load_k(const bf16* kp, bf16x8 (&k)[4]) {
#pragma unroll
    for (int st = 0; st < 4; ++st) k[st] = *(const bf16x8*)(kp + 16 * st);
}
__device__ __forceinline__ void store_o(LAS unsigned char* ot, bf16* op  , const f32x16& O0, const f32x16& O1, int lane) {
    const int c = lane & 31, hi = lane >> 5;
#pragma unroll
    for (int r = 0; r < 16; ++r) { LAS unsigned char* p = ot + crow(r, hi) * OTSTR + 2 * c; *(LAS unsigned short*)p = (unsigned short)f2bf(O0[r]); *(LAS unsigned short*)(p + 64) = (unsigned short)f2bf(O1[r]); }
#pragma unroll
    for (int i = 0; i < 4; ++i) { const int row = i * 8 + (lane >> 3), ch = lane & 7; *(bf16x8*)(op + (size_t)row * DM + 8 * ch) = *(const LAS bf16x8*)(ot + row * OTSTR + 16 * ch); }
}

__device__ __forceinline__ void swa_unit(const bf16* qkv, bf16* obuf, const float* sinks, int b, int hq, int qb, LAS unsigned char* vt, int lane) {
    const int c = lane & 31, hi = lane >> 5, kvh = hq >> 2;
    const size_t rowbase = (size_t)b * SEQ;
    const bf16* qp = qkv + (rowbase + qb * 32 + c) * AIN + hq * 64 + 8 * hi;
    bf16x8 qf[4]; load_k(qp, qf);
    bf16x8 kf[5][4];
#pragma unroll
    for (int i = 0; i < 5; ++i) { const int kb = qb - 4 + i; if (kb >= 0) load_k(qkv + (rowbase + kb * 32 + c) * AIN + 512 + kvh * 64 + 8 * hi, kf[i]); }
    const bf16* vbase = qkv + rowbase * AIN + 640 + kvh * 64;
    const int i0 = qb >= 4 ? 0 : 4 - qb;
    bf16x8 vcur[4], vnext[4];
    load_v(vbase + (size_t)(qb - 4 + i0) * 32 * AIN, AIN, lane, vcur);
    const float slope = exp2f(-(float)(hq + 1)), sink = sinks[hq];
    f32x16 X[5]; float mx = -INFINITY;
#pragma unroll
    for (int i = 0; i < 5; ++i) { const int kb = qb - 4 + i;
        f32x16 a;
#pragma unroll
        for (int r = 0; r < 16; ++r) a[r] = 0.f;
        if (kb >= 0) {
#pragma unroll
            for (int st = 0; st < 4; ++st) a = MFMA32(kf[i][st], qf[st], a);
#pragma unroll
            for (int r = 0; r < 16; ++r) { const int dist = (qb * 32 + c) - (kb * 32 + crow(r, hi)); const bool valid = dist >= 0 && dist < 128;
                const float s = valid ? a[r] * 0.125f - slope * (float)dist : -INFINITY; a[r] = s; mx = fmaxf(mx, s); }
        } else {
#pragma unroll
            for (int r = 0; r < 16; ++r) a[r] = -INFINITY;
        }
        X[i] = a; }
    mx = fmaxf(mx, __shfl_xor(mx, 32)); mx = fmaxf(mx, sink);
    float sum = 0.f;
#pragma unroll
    for (int i = 0; i < 5; ++i)
#pragma unroll
        for (int r = 0; r < 16; ++r) { const float p = __expf(X[i][r] - mx); X[i][r] = p; sum += p; }
    sum += __shfl_xor(sum, 32);
    const float inv = 1.0f / (sum + __expf(sink - mx));
    f32x16 O0, O1;
#pragma unroll
    for (int r = 0; r < 16; ++r) { O0[r] = 0.f; O1[r] = 0.f; }
#pragma unroll
    for (int i = 0; i < 5; ++i) { const int kb = qb - 4 + i;
        if (kb >= 0) {
            if (i < 4) load_v(vbase + (size_t)(kb + 1) * 32 * AIN, AIN, lane, vnext);
            stage_vt(vt, lane, vcur);
#pragma unroll
            for (int s2 = 0; s2 < 2; ++s2) {
                const bf16x8 pf = packf8(X[i][8 * s2 + 0] * inv, X[i][8 * s2 + 1] * inv, X[i][8 * s2 + 2] * inv, X[i][8 * s2 + 3] * inv, X[i][8 * s2 + 4] * inv, X[i][8 * s2 + 5] * inv, X[i][8 * s2 + 6] * inv, X[i][8 * s2 + 7] * inv);
                O0 = MFMA32(pf, read_vt(vt, c, s2, hi), O0); O1 = MFMA32(pf, read_vt(vt, c + 32, s2, hi), O1); }
            if (i < 4) {
#pragma unroll
                for (int k = 0; k < 4; ++k) vcur[k] = vnext[k]; }
        } }
    store_o(vt + VT_BYTES, obuf + (rowbase + qb * 32) * DM + hq * 64, O0, O1, lane);
}

__device__ __forceinline__ void sb_unit(const bf16* qkv, bf16* obuf, int b, int h, int qb, LAS unsigned char* vt, int lane) {
    const int c = lane & 31, hi = lane >> 5, t = qb * 32 + c;
    const size_t rowbase = (size_t)b * SEQ;
    bf16x8 qf[4]; load_k(qkv + (rowbase + t) * AIN + 768 + h * 64 + 8 * hi, qf);
    const bf16* kbase = qkv + (rowbase + c) * AIN + 1280 + h * 64 + 8 * hi;
    const bf16* vbase = qkv + rowbase * AIN + 1792 + h * 64;
    bf16x8 kf[4], vf[4], kn[4], vn[4];
    load_k(kbase + (size_t)qb * 32 * AIN, kf); load_v(vbase + (size_t)qb * 32 * AIN, AIN, lane, vf);
    float carry = 0.f;
    f32x16 O0, O1;
#pragma unroll
    for (int r = 0; r < 16; ++r) { O0[r] = 0.f; O1[r] = 0.f; }
    for (int kb = qb; kb >= 0; --kb) {
        { const int kbn = kb > 0 ? kb - 1 : 0; load_k(kbase + (size_t)kbn * 32 * AIN, kn); load_v(vbase + (size_t)kbn * 32 * AIN, AIN, lane, vn); }
        f32x16 a;
#pragma unroll
        for (int r = 0; r < 16; ++r) a[r] = 0.f;
#pragma unroll
        for (int st = 0; st < 4; ++st) a = MFMA32(kf[st], qf[st], a);
        float lk[16], lsg[16];
#pragma unroll
        for (int r = 0; r < 16; ++r) { const float z = a[r] * 0.125f; const bool causal = (kb * 32 + crow(r, hi)) < t;
            const float sp = fmaxf(z, 0.f) + __logf(1.0f + __expf(-fabsf(z)));
            lk[r] = causal ? -sp : 0.f; lsg[r] = z - sp; }
        float G[4], Gp[4];
#pragma unroll
        for (int g = 0; g < 4; ++g) { G[g] = (lk[4 * g] + lk[4 * g + 1]) + (lk[4 * g + 2] + lk[4 * g + 3]); Gp[g] = __shfl_xor(G[g], 32); }
        float tail = 0.f; f32x16 w;
#pragma unroll
        for (int g = 3; g >= 0; --g) { const float base = carry + tail + (hi == 0 ? Gp[g] : 0.f); float run = 0.f;
#pragma unroll
            for (int i = 3; i >= 0; --i) { const int r = 4 * g + i; const bool causal = (kb * 32 + crow(r, hi)) < t;
                w[r] = causal ? __expf(lsg[r] + base + run) : 0.f; run += lk[r]; }
            tail += G[g] + Gp[g]; }
        carry += tail;
        stage_vt(vt, lane, vf);
#pragma unroll
        for (int s2 = 0; s2 < 2; ++s2) {
            const bf16x8 pf = packf8(w[8 * s2 + 0], w[8 * s2 + 1], w[8 * s2 + 2], w[8 * s2 + 3], w[8 * s2 + 4], w[8 * s2 + 5], w[8 * s2 + 6], w[8 * s2 + 7]);
            O0 = MFMA32(pf, read_vt(vt, c, s2, hi), O0); O1 = MFMA32(pf, read_vt(vt, c + 32, s2, hi), O1); }
        if (__all(carry < SB_EXIT)) break;
#pragma unroll
        for (int k = 0; k < 4; ++k) { kf[k] = kn[k]; vf[k] = vn[k]; }
    }
    store_o(vt + VT_BYTES, obuf + (rowbase + qb * 32) * DM + 512 + h * 64, O0, O1, lane);
}

__device__ __forceinline__ void attn_phase(const Ptrs& P, LAS unsigned char* lds, int wave, int lane) {
    const bf16* qkv = (const bf16*)(P.ws + WS_ACT); bf16* obuf = (bf16*)(P.ws + WS_OB);
    LAS unsigned char* vt = lds + RING_OFF + wave * 10240;
    const int gw = blockIdx.x * NWAVES + wave, NGW = gridDim.x * NWAVES;
    constexpr int NU = BATCH * 8 * (SEQ / 32);
    for (int u = gw; u < 2 * NU; u += NGW) {
        if (u < NU) { const int qb = (SEQ / 32 - 1) - (u >> 6), bh = u & 63; sb_unit(qkv, obuf, bh >> 3, bh & 7, qb, vt, lane); }
        else { const int v = u - NU, qb = v >> 6, bh = v & 63; swa_unit(qkv, obuf, P.attn_sinks, bh >> 3, bh & 7, qb, vt, lane); }
    }
}

constexpr int KSTR = 144;
constexpr int QSTR = 272;
constexpr int OSTR = 132;
constexpr int L_TOT = 0, L_GL = 2048, L_KS = L_GL + 64 * OSTR * 4, L_VT = L_KS + 128 * KSTR, L_RZ = L_VT + 128 * KSTR, L_RV = L_RZ + 64 * QSTR, L_A_END = L_RV + 64 * QSTR;
constexpr int L_QI = L_KS, L_QX = L_QI + 64 * QSTR, L_KX = L_QX + 64 * QSTR, L_VT2 = L_KX + 64 * QSTR, L_OF = L_GL, L_RS = L_VT2 + 128 * KSTR, L_C_END = L_RS + 256;
static_assert(L_A_END <= RING_BYTES && L_C_END <= RING_BYTES, "HGRN2 LDS map");

__device__ __forceinline__ float hgrn_lb(const float* logits, int col) {
    const float l0 = logits[col], l1 = logits[512 + col]; return 1.0f / (1.0f + __expf(l0 - l1));
}
__device__ __forceinline__ void tile_load(const bf16* src, int tid, bf16x8 (&r)[2]) {
#pragma unroll
    for (int i = 0; i < 2; ++i) { const int ci = tid + 512 * i; r[i] = *(const bf16x8*)(src + (size_t)(ci >> 4) * RIN + 8 * (ci & 15)); }
}
__device__ __forceinline__ void tile_to_lds(LAS unsigned char* dst, int tid, const bf16x8 (&r)[2]) {
#pragma unroll
    for (int i = 0; i < 2; ++i) { const int ci = tid + 512 * i; *(LAS bf16x8*)(dst + (ci >> 4) * QSTR + 16 * (ci & 15)) = r[i]; }
}
__device__ __forceinline__ float lds_bf(const LAS unsigned char* img, int t, int d) { return bf2f(*(const LAS unsigned short*)(img + t * QSTR + 2 * d)); }
__device__ __forceinline__ void hgrn_gates(const LAS unsigned char* rz, int d, int tq, float lbv, LAS float* tot, LAS float* GL) {
    float cum = 0.f;
#pragma unroll
    for (int j = 0; j < 16; ++j) { const float z = lds_bf(rz, tq * 16 + j, d);
        const float sg = 1.0f / (1.0f + __expf(-z)); cum += __logf(lbv + (1.0f - lbv) * sg); GL[(tq * 16 + j) * 128 + d] = cum; }
    tot[tq * 128 + d] = cum;
    __syncthreads();
}

__device__ __forceinline__ void rec_pass_a(const Ptrs& P, LAS unsigned char* lds, int wave, int lane) {
    const bf16* qkv = (const bf16*)(P.ws + WS_ACT); bf16* obuf = (bf16*)(P.ws + WS_OB);
    bf16* st = (bf16*)(P.ws + WS_ST); float* dec = (float*)(P.ws + WS_DEC);
    const int tid = threadIdx.x, d = tid & 127, tq = tid >> 7, c = lane & 31, hi = lane >> 5, G = gridDim.x;
    LAS float* tot = (LAS float*)(lds + L_TOT); LAS float* GL = (LAS float*)(lds + L_GL);
    bf16x8 pz[2], pv[2];
    int u = blockIdx.x;
    if (u < 1024) { const bf16* src = qkv + ((size_t)(u >> 7) * SEQ + (u & 31) * 64) * RIN + ((u >> 5) & 3) * 128; tile_load(src + 512, tid, pz); tile_load(src + 1024, tid, pv); }
    for (; u < 1024; u += G) {
        const int hh = (u >> 5) & 3;
        tile_to_lds(lds + L_RZ, tid, pz); tile_to_lds(lds + L_RV, tid, pv);
        { const int un = u + G; if (un < 1024) { const bf16* src = qkv + ((size_t)(un >> 7) * SEQ + (un & 31) * 64) * RIN + ((un >> 5) & 3) * 128; tile_load(src + 512, tid, pz); tile_load(src + 1024, tid, pv); } }
        __syncthreads();
        const float lbv = hgrn_lb(P.lb_logits, hh * 128 + d);
        hgrn_gates(lds + L_RZ, d, tq, lbv, tot, GL);
        float off = 0.f;
#pragma unroll
        for (int q = 0; q < 3; ++q) off += (q < tq) ? tot[q * 128 + d] : 0.f;
        const float glast = tot[d] + tot[128 + d] + tot[256 + d] + tot[384 + d];
        if (tq == 0) dec[u * 128 + d] = __expf(glast);
#pragma unroll
        for (int grp = 0; grp < 2; ++grp) {
            float ks[8]; bf16x8 vv;
#pragma unroll
            for (int j = 0; j < 8; ++j) { const int t = tq * 16 + grp * 8 + j; const float z = lds_bf(lds + L_RZ, t, d), g = GL[t * 128 + d] + off;
                ks[j] = (1.0f - lbv) / (1.0f + __expf(z)) * __expf(glast - g); vv[j] = *(const LAS short*)(lds + L_RV + t * QSTR + 2 * d); }
            *(LAS bf16x8*)(lds + L_KS + d * KSTR + tq * 32 + grp * 16) = packf8(ks[0], ks[1], ks[2], ks[3], ks[4], ks[5], ks[6], ks[7]);
            *(LAS bf16x8*)(lds + L_VT + d * KSTR + tq * 32 + grp * 16) = vv;
        }
        __syncthreads();
        const int eb = wave >> 1;
        LAS unsigned char* img = lds + (wave < 4 ? L_GL + wave * 4608 : L_RZ + (wave - 4) * 4608);
#pragma unroll
        for (int dbi = 0; dbi < 2; ++dbi) { const int db = 2 * (wave & 1) + dbi;
            f32x16 acc;
#pragma unroll
            for (int r = 0; r < 16; ++r) acc[r] = 0.f;
#pragma unroll
            for (int s = 0; s < 4; ++s) acc = MFMA32(*(const LAS bf16x8*)(lds + L_VT + (eb * 32 + c) * KSTR + 32 * s + 16 * hi), *(const LAS bf16x8*)(lds + L_KS + (db * 32 + c) * KSTR + 32 * s + 16 * hi), acc);
#pragma unroll
            for (int r = 0; r < 16; ++r) *(LAS unsigned short*)(img + crow(r, hi) * 144 + dbi * 64 + 2 * c) = (unsigned short)f2bf(acc[r]); }
        { bf16* sp = st + ((size_t)u * 128 + eb * 32) * 128 + (wave & 1) * 64;
#pragma unroll
            for (int i = 0; i < 4; ++i) { const int q = lane + 64 * i, row = q >> 3, chk = q & 7; *(bf16x8*)(sp + (size_t)row * 128 + 8 * chk) = *(const LAS bf16x8*)(img + row * 144 + 16 * chk); } }
        __syncthreads();
    }
    const int gid = blockIdx.x * (NWAVES * 64) + tid, NT = gridDim.x * NWAVES * 64;
#pragma unroll 2
    for (int it = gid; it < M * 64; it += NT) {
        const int row = it >> 6, c8 = (it & 63) * 8, t = row & (SEQ - 1);
        const bf16* rp = qkv + (size_t)row * RIN; const bf16* rp1 = t >= 1 ? rp - RIN : rp; const bf16* rp2 = t >= 2 ? rp - 2 * RIN : rp;
        const float m1 = t >= 1 ? 1.f : 0.f, m2 = t >= 2 ? 1.f : 0.f;
        const bf16x8 gb = *(const bf16x8*)(rp + 2048 + c8), gc0 = *(const bf16x8*)(rp + 2560 + c8), u0 = *(const bf16x8*)(rp + 3072 + c8);
        const bf16x8 gc1 = *(const bf16x8*)(rp1 + 2560 + c8), u1 = *(const bf16x8*)(rp1 + 3072 + c8), gc2 = *(const bf16x8*)(rp2 + 2560 + c8), u2 = *(const bf16x8*)(rp2 + 3072 + c8);
        const f32x4 w0a = *(const f32x4*)(P.conv_w + c8), w0b = *(const f32x4*)(P.conv_w + c8 + 4), w1a = *(const f32x4*)(P.conv_w + 512 + c8), w1b = *(const f32x4*)(P.conv_w + 512 + c8 + 4), w2a = *(const f32x4*)(P.conv_w + 1024 + c8), w2b = *(const f32x4*)(P.conv_w + 1024 + c8 + 4);
        float o[8];
#pragma unroll
        for (int j = 0; j < 8; ++j) { const float w0 = j < 4 ? w0a[j & 3] : w0b[j & 3], w1 = j < 4 ? w1a[j & 3] : w1b[j & 3], w2 = j < 4 ? w2a[j & 3] : w2b[j & 3];
            const float x0 = bf2f((unsigned short)gc0[j]) * bf2f((unsigned short)u0[j]), x1 = m1 * bf2f((unsigned short)gc1[j]) * bf2f((unsigned short)u1[j]), x2 = m2 * bf2f((unsigned short)gc2[j]) * bf2f((unsigned short)u2[j]);
            o[j] = bf2f((unsigned short)gb[j]) * (w0 * x2 + w1 * x1 + w2 * x0); }
        *(bf16x8*)(obuf + (size_t)row * DM + 512 + c8) = packf8(o[0], o[1], o[2], o[3], o[4], o[5], o[6], o[7]);
    }
}

__device__ __forceinline__ void rec_pass_b(const Ptrs& P) {
    const bf16* st = (const bf16*)(P.ws + WS_ST); const float* dec = (const float*)(P.ws + WS_DEC); bf16* sb = (bf16*)(P.ws + WS_SB);
    const int gid = blockIdx.x * (NWAVES * 64) + threadIdx.x, NT = gridDim.x * NWAVES * 64;
    for (int x = gid; x < 32 * 4096; x += NT) {
        const int seq = x >> 12, ed = (x & 4095) * 4, d = ed & 127; f32x4 S = {0.f, 0.f, 0.f, 0.f};
#pragma unroll 1
        for (int half = 0; half < 2; ++half) {
            f32x4 kv[16], dc[16];
#pragma unroll
            for (int i = 0; i < 16; ++i) { const size_t u = (size_t)seq * 32 + half * 16 + i; { const u32x2v kw = *(const u32x2v*)(st + u * 16384 + ed); kv[i] = pg8::bf2x_lo(kw.x, kw.y); } dc[i] = *(const f32x4*)(dec + u * 128 + d); }
#pragma unroll
            for (int i = 0; i < 16; ++i) { const size_t u = (size_t)seq * 32 + half * 16 + i;
                u32x2v w; w.x = pg8::cvt_pk_bf16(S[0], S[1]); w.y = pg8::cvt_pk_bf16(S[2], S[3]); *(u32x2v*)(sb + u * 16384 + ed) = w;
                S = dc[i] * S + kv[i]; }
        }
    }
}

__device__ __forceinline__ void rec_pass_c(const Ptrs& P, LAS unsigned char* lds, int wave, int lane) {
    const bf16* qkv = (const bf16*)(P.ws + WS_ACT); bf16* obuf = (bf16*)(P.ws + WS_OB); const bf16* sb = (const bf16*)(P.ws + WS_SB);
    const int tid = threadIdx.x, d = tid & 127, tq = tid >> 7, c = lane & 31, hi = lane >> 5, G = gridDim.x;
    const int tb = wave & 1, eb = wave >> 1;
    LAS float* tot = (LAS float*)(lds + L_TOT); LAS float* GL = (LAS float*)(lds + L_GL); LAS float* OF = (LAS float*)(lds + L_OF); LAS float* RS = (LAS float*)(lds + L_RS);
    bf16x8 pq[2], pz[2], pv[2];
    int u = blockIdx.x;
    if (u < 1024) { const bf16* src = qkv + ((size_t)(u >> 7) * SEQ + (u & 31) * 64) * RIN + ((u >> 5) & 3) * 128; tile_load(src, tid, pq); tile_load(src + 512, tid, pz); tile_load(src + 1024, tid, pv); }
    for (; u < 1024; u += G) {
        const int b = u >> 7, hh = (u >> 5) & 3, ch = u & 31; const size_t row0 = (size_t)b * SEQ + ch * 64;
        tile_to_lds(lds + L_QI, tid, pq); tile_to_lds(lds + L_KX, tid, pz); tile_to_lds(lds + L_QX, tid, pv);
        bf16x8 sf[8], pg[2];
        { const bf16* sp = sb + ((size_t)u * 128 + eb * 32 + c) * 128 + 8 * hi;
#pragma unroll
            for (int s = 0; s < 8; ++s) sf[s] = *(const bf16x8*)(sp + 16 * s); }
        tile_load(qkv + row0 * RIN + 1536 + hh * 128, tid, pg);
        { const int un = u + G; if (un < 1024) { const bf16* src = qkv + ((size_t)(un >> 7) * SEQ + (un & 31) * 64) * RIN + ((un >> 5) & 3) * 128; tile_load(src, tid, pq); tile_load(src + 512, tid, pz); tile_load(src + 1024, tid, pv); } }
        __syncthreads();
        const float lbv = hgrn_lb(P.lb_logits, hh * 128 + d);
        hgrn_gates(lds + L_KX, d, tq, lbv, tot, GL);
        float off = 0.f;
#pragma unroll
        for (int q = 0; q < 3; ++q) off += (q < tq) ? tot[q * 128 + d] : 0.f;
        const float gref = tot[d] + tot[128 + d];
#pragma unroll
        for (int grp = 0; grp < 2; ++grp) { bf16x8 vv;
#pragma unroll
            for (int k = 0; k < 8; ++k) { const int j = (k & 3) + 8 * (k >> 2) + 4 * grp; vv[k] = *(const LAS short*)(lds + L_QX + (tq * 16 + j) * QSTR + 2 * d); }
            *(LAS bf16x8*)(lds + L_VT2 + d * KSTR + tq * 32 + grp * 16) = vv; }
#pragma unroll 4
        for (int j = 0; j < 16; ++j) { const int t = tq * 16 + j;
            const float qv = lds_bf(lds + L_QI, t, d), z = lds_bf(lds + L_KX, t, d), g = GL[t * 128 + d] + off, sq = pg8::silu_f(qv);
            const float kx = (1.0f - lbv) / (1.0f + __expf(z)) * __expf(fminf(gref - g, 80.f));
            *(LAS unsigned short*)(lds + L_QI + t * QSTR + 2 * d) = (unsigned short)f2bf(sq * __expf(g));
            *(LAS unsigned short*)(lds + L_QX + t * QSTR + 2 * d) = (unsigned short)f2bf(sq * __expf(fminf(g - gref, 80.f)));
            *(LAS unsigned short*)(lds + L_KX + t * QSTR + 2 * d) = (unsigned short)f2bf(kx); }
        __syncthreads();
        f32x16 acc;
#pragma unroll
        for (int r = 0; r < 16; ++r) acc[r] = 0.f;
#pragma unroll
        for (int s = 0; s < 8; ++s) acc = MFMA32(*(const LAS bf16x8*)(lds + L_QI + (tb * 32 + c) * QSTR + 32 * s + 16 * hi), sf[s], acc);
        for (int sbk = 0; sbk <= tb; ++sbk) {
            f32x16 X;
#pragma unroll
            for (int r = 0; r < 16; ++r) X[r] = 0.f;
#pragma unroll
            for (int s = 0; s < 8; ++s) X = MFMA32(*(const LAS bf16x8*)(lds + L_KX + (sbk * 32 + c) * QSTR + 32 * s + 16 * hi), *(const LAS bf16x8*)(lds + L_QX + (tb * 32 + c) * QSTR + 32 * s + 16 * hi), X);
#pragma unroll
            for (int r = 0; r < 16; ++r) X[r] = (sbk * 32 + crow(r, hi) <= tb * 32 + c) ? X[r] : 0.f;
#pragma unroll
            for (int s2 = 0; s2 < 2; ++s2) {
                const bf16x8 pf = packf8(X[8 * s2 + 0], X[8 * s2 + 1], X[8 * s2 + 2], X[8 * s2 + 3], X[8 * s2 + 4], X[8 * s2 + 5], X[8 * s2 + 6], X[8 * s2 + 7]);
                acc = MFMA32(pf, *(const LAS bf16x8*)(lds + L_VT2 + (eb * 32 + c) * KSTR + sbk * 64 + 32 * s2 + 16 * hi), acc); }
        }
#pragma unroll
        for (int r = 0; r < 16; ++r) OF[(tb * 32 + crow(r, hi)) * OSTR + eb * 32 + c] = acc[r];
        __syncthreads();
        { const int t = tid >> 3, pt = tid & 7; float ss = 0.f;
#pragma unroll
            for (int k = 0; k < 16; ++k) { const float v = OF[t * OSTR + pt * 16 + k]; ss += v * v; }
            ss += __shfl_xor(ss, 1); ss += __shfl_xor(ss, 2); ss += __shfl_xor(ss, 4);
            if (pt == 0) RS[t] = 1.0f / sqrtf(ss * (1.0f / 128.0f) + pg8::RMS_EPS); }
        __syncthreads();
#pragma unroll
        for (int i = 0; i < 2; ++i) { const int ci = tid + 512 * i, t = ci >> 4, e8 = 8 * (ci & 15);
            const f32x4 o0 = *(const LAS f32x4*)(OF + t * OSTR + e8), o1 = *(const LAS f32x4*)(OF + t * OSTR + e8 + 4);
            const f32x4 g0 = *(const f32x4*)(P.hgrn_norm_g + e8), g1 = *(const f32x4*)(P.hgrn_norm_g + e8 + 4); const float rs = RS[t];
            float o[8];
#pragma unroll
            for (int k = 0; k < 8; ++k) { const float gate = bf2f((unsigned short)pg[i][k]); o[k] = (k < 4 ? o0[k & 3] * g0[k & 3] : o1[k & 3] * g1[k & 3]) * rs * pg8::silu_f(gate); }
            *(bf16x8*)(obuf + (row0 + t) * DM + hh * 128 + e8) = packf8(o[0], o[1], o[2], o[3], o[4], o[5], o[6], o[7]); }
        __syncthreads();
    }
}

#ifndef STAGGER_TICKS
#define STAGGER_TICKS 800
#endif
__device__ __forceinline__ void stagger_delay(int nwg, int G, int c) {
    const int rem = nwg % G;
    if (rem == 0 || c < rem || STAGGER_TICKS == 0) return;
    const int j = ((c - rem) * 2) / (G - rem);
    const unsigned long long t0 = __builtin_amdgcn_s_memrealtime(), dt = (unsigned long long)(j + 1) * STAGGER_TICKS;
    while (__builtin_amdgcn_s_memrealtime() - t0 < dt) __builtin_amdgcn_s_sleep(32);
}

__device__ __forceinline__ void flat_barrier(unsigned* cnt, unsigned* tmo, volatile LAS unsigned* ep) {
    asm volatile("s_waitcnt vmcnt(0)" ::: "memory");
    __syncthreads();
    if (threadIdx.x == 0) {
        const unsigned e = ep[0]; ep[0] = e + 1u;
        __builtin_amdgcn_fence(__ATOMIC_RELEASE, "agent");
        asm volatile("s_waitcnt vmcnt(0)" ::: "memory");
        (void)__hip_atomic_fetch_add(cnt, 1u, __ATOMIC_RELAXED, __HIP_MEMORY_SCOPE_AGENT);
        const unsigned target = (e + 1u) * gridDim.x; unsigned sp = 0;
        while (xb_ld(cnt) < target) { __builtin_amdgcn_s_sleep(2); if ((++sp & 1023u) == 0u) { if (xb_ld(tmo)) break; if (sp > (1u << 20)) { atomicAdd(tmo, 1u); break; } } }
        __builtin_amdgcn_fence(__ATOMIC_ACQUIRE, "agent");
        asm volatile("s_waitcnt vmcnt(0)" ::: "memory");
    }
    __syncthreads();
}
#ifndef FLAT_BAR
#define FLAT_BAR 0
#endif
#if FLAT_BAR
#define GRID_BARRIER() flat_barrier((unsigned*)(ctl + CW_BAR + 64), (unsigned*)(ctl + CW_BAR + 128), MISC + 10)
#else
#define GRID_BARRIER() xcd_barrier(bar)
#endif

constexpr int N_PHASES = 18;
struct Args { Ptrs p; int ph_lo, ph_hi; };
__global__ void __launch_bounds__(NWAVES * 64, 2) trunk_fwd(Args args) {
    extern __shared__ __attribute__((aligned(16))) unsigned char lds_raw[];
    LAS unsigned char* lds = (LAS unsigned char*)lds_raw;
    volatile LAS unsigned* MISC = (volatile LAS unsigned*)(lds + MISC_OFF);
    const int tid = threadIdx.x, lane = tid & 63, wave = __builtin_amdgcn_readfirstlane(tid >> 6);
    const Ptrs& P = args.p;
    unsigned char* ws = P.ws;
    gu32* ctl = (gu32*)(ws + WS_CTL);
    for (int u = tid; u < (LDS_BYTES - LDSCTL_OFF) / 4; u += NWAVES * 64) ((LAS unsigned*)(lds + LDSCTL_OFF))[u] = 0u;
    __syncthreads();
    const int lo = args.ph_lo, hi = args.ph_hi;
    XcdBarrier bar; bar.bar = (unsigned*)(ctl + CW_BAR); bar.x = 0; bar.st = nullptr;
    if (hi - lo > 1 && !FLAT_BAR) bar = xcd_barrier_post((unsigned*)(ctl + CW_BAR), MISC + 8);
#define IN(k) (lo <= (k) && (k) < hi)
#define SEAM(k) do { if (IN(k) && IN((k) + 1)) GRID_BARRIER(); } while (0)
    bf16* hb = (bf16*)(ws + WS_HB); bf16* ob = (bf16*)(ws + WS_OB); bf16* act = (bf16*)(ws + WS_ACT); float* part = (float*)(ws + WS_PART);
    const int G = gridDim.x, bx = blockIdx.x;

#ifndef DUP_MASK
#define DUP_MASK 0u
#endif
#ifndef EXTRA_BARS
#define EXTRA_BARS 0
#endif
#define DUP(k) ((DUP_MASK >> (k)) & 1u)
    if (IN(0)) { if (DUP(0)) { p0_prologue(P, lds, wave, lane); GRID_BARRIER(); } p0_prologue(P, lds, wave, lane); } SEAM(0);
    for (int eb_ = 0; eb_ < EXTRA_BARS; ++eb_) GRID_BARRIER();
#define WFIN(i) ((const bf16*)(ws + WS_WFIN) + (size_t)(i) * 2 * FF * DM)
#define WFOUT(i) ((const bf16*)(ws + WS_WFOUT) + (size_t)(i) * DM * FF)
#ifndef PROBE_EPI
#define PROBE_EPI 0
#endif
#define PH_FFN_IN(k, wi, CA, CB, CC) do { if (IN(k)) { if (DUP(k)) { pg8::Gemm g{hb, WFIN(wi), M, 2 * FF, DM}; pg8::StaticOrder S; S.init(M, 2 * FF, G, bx); \
        pg8::EpiSwigluT<PROBE_EPI> E{act, FF, part}; pg8::gemm_phase<pg8::EpiSwigluT<PROBE_EPI>, pg8::StaticOrder, true, true>(lds + RING_OFF, g, S, E); GRID_BARRIER(); } \
        convert_in_slack<CA, CB, CC>(P, lds, wave, lane, (M / 256) * (2 * FF / 256)); \
        pg8::Gemm g{hb, WFIN(wi), M, 2 * FF, DM}; pg8::StaticOrder S; S.init(M, 2 * FF, G, bx); \
        pg8::EpiSwiglu E{act, FF, part}; pg8::gemm_phase<pg8::EpiSwiglu, pg8::StaticOrder, true, true>(lds + RING_OFF, g, S, E); } SEAM(k); } while (0)
#define PH_FFN_OUT_(k, wi, obp, partp) do { pg8::Gemm g{act, WFOUT(wi), M, DM, FF}; pg8::StaticOrder S; S.init(M, DM, G, bx); \
        pg8::EpiResid E{hb, obp, partp, 0.5f}; pg8::gemm_phase<pg8::EpiResid, pg8::StaticOrder, true, true>(lds + RING_OFF, g, S, E); } while (0)
#define PH_FFN_OUT(k, wi) do { if (IN(k)) { if (DUP(k)) { PH_FFN_OUT_(k, wi, ob, (float*)(ws + WS_END)); GRID_BARRIER(); } PH_FFN_OUT_(k, wi, hb, part); } SEAM(k); } while (0)
#define PH_MIX_IN(k, woff, NN, CA, CB, CC) do { if (IN(k)) for (int rep_ = DUP(k) ? 2 : 1; rep_ > 0; --rep_) { if (rep_ == 1 && DUP(k)) GRID_BARRIER(); if (rep_ == 1) convert_in_slack<CA, CB, CC>(P, lds, wave, lane, (M / 256) * ((NN) / 256)); pg8::Gemm g{hb, (const bf16*)(ws + (woff)), M, NN, DM}; pg8::StaticOrder S; S.init(M, NN, G, bx); \
        pg8::EpiRowScale E{act, NN, part}; pg8::gemm_phase<pg8::EpiRowScale, pg8::StaticOrder, true, true>(lds + RING_OFF, g, S, E); } SEAM(k); } while (0)
#define PH_MIX_OUT_(k, woff, obp, partp) do { pg8::Gemm g{ob, (const bf16*)(ws + (woff)), M, DM, DM}; pg8::StaticOrder S; S.init(M, DM, G, bx); \
        pg8::EpiResid E{hb, obp, partp, 1.0f}; pg8::gemm_phase<pg8::EpiResid, pg8::StaticOrder, true, true>(lds + RING_OFF, g, S, E); } while (0)
#define PH_MIX_OUT(k, woff) do { if (IN(k)) { if (DUP(k)) { PH_MIX_OUT_(k, woff, act, (float*)(ws + WS_END)); GRID_BARRIER(); } PH_MIX_OUT_(k, woff, hb, part); } SEAM(k); } while (0)
    PH_FFN_IN(1, 0, 4, 8, 9); PH_FFN_OUT(2, 0);
    PH_MIX_IN(3, WS_WAIN, AIN, 1, 5, -1);
    if (IN(4)) { if (DUP(4)) { attn_phase(P, lds, wave, lane); GRID_BARRIER(); } attn_phase(P, lds, wave, lane); } SEAM(4);
    PH_MIX_OUT(5, WS_WAOUT);
    PH_FFN_IN(6, 1, 2, -1, -1); PH_FFN_OUT(7, 1);
    PH_FFN_IN(8, 2, 6, 10, 11); PH_FFN_OUT(9, 2);
    PH_MIX_IN(10, WS_WRIN, RIN, 3, 7, -1);
    if (IN(11)) { if (DUP(11)) { rec_pass_a(P, lds, wave, lane); GRID_BARRIER(); } rec_pass_a(P, lds, wave, lane); } SEAM(11);
    if (IN(12)) { if (DUP(12)) { rec_pass_b(P); GRID_BARRIER(); } rec_pass_b(P); } SEAM(12);
    if (IN(13)) { if (DUP(13)) { rec_pass_c(P, lds, wave, lane); GRID_BARRIER(); } rec_pass_c(P, lds, wave, lane); } SEAM(13);
    PH_MIX_OUT(14, WS_WROUT);
    PH_FFN_IN(15, 3, -1, -1, -1); PH_FFN_OUT(16, 3);
    if (IN(N_PHASES - 1)) final_norm(P, wave, lane);
#undef IN
#undef SEAM
}

#ifndef MK_PER_PHASE
#define MK_PER_PHASE 0
#endif
extern "C" void kernel_launch(void* const* d_in, const int* in_sizes, int n_in, void* d_out, int out_size, void* d_ws, size_t ws_size, hipStream_t stream) {
    static int grid = 0;
    if (grid == 0) {
        if (n_in != 13 || in_sizes[0] != M * DM || out_size != M * DM || ws_size < WS_END + MiB) { fprintf(stderr, "kernel_launch: unexpected shapes (n_in %d, in0 %d, out %d, ws %zu); nothing launched\n", n_in, n_in > 0 ? in_sizes[0] : -1, out_size, ws_size); grid = -1; return; }
        int dev = 0, cus = 0, per_cu = 0;
        if (hipGetDevice(&dev) != hipSuccess || hipDeviceGetAttribute(&cus, hipDeviceAttributeMultiprocessorCount, dev) != hipSuccess) { grid = -1; return; }
        if (hipFuncSetAttribute((const void*)trunk_fwd, hipFuncAttributeMaxDynamicSharedMemorySize, LDS_BYTES) != hipSuccess) { fprintf(stderr, "kernel_launch: hipFuncSetAttribute failed\n"); grid = -1; return; }
        if (hipOccupancyMaxActiveBlocksPerMultiprocessor(&per_cu, (const void*)trunk_fwd, NWAVES * 64, LDS_BYTES) != hipSuccess || per_cu < 1) { fprintf(stderr, "kernel_launch: occupancy query says %d blocks per CU\n", per_cu); per_cu = 1; }
        (void)hipGetLastError();
        grid = cus;
    }
    if (grid < 0) return;
    (void)hipMemsetAsync((char*)d_ws + WS_CTL, 0, CTL_ZERO_BYTES, stream);
    Args a{};
    const float** pp = (const float**)&a.p;
    for (int i = 0; i < 13; ++i) pp[i] = (const float*)d_in[i];
    a.p.out = (float*)d_out; a.p.ws = (unsigned char*)d_ws;
#if MK_PER_PHASE
    for (int k = 0; k < N_PHASES; ++k) { a.ph_lo = k; a.ph_hi = k + 1; hipLaunchKernelGGL(trunk_fwd, dim3(grid), dim3(NWAVES * 64), LDS_BYTES, stream, a); }
#else
    a.ph_lo = 0; a.ph_hi = N_PHASES; hipLaunchKernelGGL(trunk_fwd, dim3(grid), dim3(NWAVES * 64), LDS_BYTES, stream, a);
#endif
}
```

```cpp
#include <hip/hip_runtime.h>
#include <cstdio>
#include <cstdint>
namespace pg8 {
#define PG8_LAS __attribute__((address_space(3)))
typedef unsigned short bf16_t;
typedef short bf16x8 __attribute__((ext_vector_type(8)));
typedef float f32x4 __attribute__((ext_vector_type(4)));
typedef unsigned u32x4 __attribute__((ext_vector_type(4)));
constexpr int BM = 256, BK = 64, HALF = 128, HTB = HALF * BK * 2  , STAGE_BYTES = 8 * HTB, NXCD = 8, WGM = 8;

__host__ __device__ __forceinline__ int lds_byte(int r, int c) { const int st = (r >> 4) * 2 + (c >> 5), rr = r & 15, cc = c & 31, ob = rr * 64 + cc * 2; return st * 1024 + (ob ^ (((ob >> 9) & 1) << 5)); }
__host__ __device__ __forceinline__ void stage_rc(int b, int& R, int& C) { const int st = b / 1024, sb = b % 1024, swz = sb ^ (((sb >> 9) & 1) << 5); R = (st >> 1) * 16 + swz / 64; C = (st & 1) * 32 + (swz % 64) / 2; }
__host__ __device__ __forceinline__ int perm32(int rho) { const int n = rho >> 4, i = rho & 15; return 8 * (i >> 2) + 4 * n + (i & 3); }

struct Unit { int pm, pn; };
struct Gemm { const bf16_t* A; const bf16_t* Bt; int M, N, K; };

struct StaticOrder {
    int nM, nN, nwg, G, c;
    __host__ __device__ void init(int M, int N, int G_, int c_) { nM = M / BM; nN = N / BM; nwg = nM * nN; G = G_; c = c_; }
    __host__ __device__ bool next(int i, Unit& u) const {
        const long L = (long)i * G + c; if (L >= nwg) return false;
        int wgid = (int)L; { const int q = nwg / NXCD, r = nwg % NXCD, xcd = wgid % NXCD, off = wgid / NXCD; wgid = (xcd < r ? xcd * (q + 1) : r * (q + 1) + (xcd - r) * q) + off; }
        const int nig = WGM * nN, gid = wgid / nig, fm = gid * WGM, gsz = (nM - fm) < WGM ? (nM - fm) : WGM;
        u.pm = fm + ((wgid % nig) % gsz); u.pn = (wgid % nig) / gsz; return true;
    }
    __device__ __forceinline__ void a_ready(const Unit&) const {}
    __device__ __forceinline__ void done(const Unit&) const {}
};
typedef float f32x2_t __attribute__((ext_vector_type(2))); typedef __bf16 bf16x2_t __attribute__((ext_vector_type(2)));
__device__ __forceinline__ unsigned cvt_pk_bf16(float lo, float hi) { f32x2_t v = {lo, hi}; bf16x2_t b = __builtin_convertvector(v, bf16x2_t); return __builtin_bit_cast(unsigned, b); }
__device__ __forceinline__ u32x4 pack8(const f32x4 a, const f32x4 b) { u32x4 w; w.x = cvt_pk_bf16(a[0], a[1]); w.y = cvt_pk_bf16(a[2], a[3]); w.z = cvt_pk_bf16(b[0], b[1]); w.w = cvt_pk_bf16(b[2], b[3]); return w; }
constexpr float RMS_EPS = 1e-6f;
__device__ __forceinline__ float row_rstd(const float* part, int row, int fq) {
    const f32x4 p = *(const f32x4*)(part + (size_t)row * 16 + fq * 4);
    float s = (p[0] + p[1]) + (p[2] + p[3]);
    s += __shfl_xor(s, 16); s += __shfl_xor(s, 32);
    return 1.0f / sqrtf(s * (1.0f / 1024.0f) + RMS_EPS);
}
__device__ __forceinline__ float silu_f(float x) { return x * __builtin_amdgcn_rcpf(1.0f + __expf(-x)); }
struct EpiRowScale {
    static constexpr bool PERM = true, AFTER_DRAIN = false;
    bf16_t* O; int ldc; const float* part;
    __device__ __forceinline__ void operator()(const f32x4 (&acc)[2][2][4][2], const Unit& u, int wr, int wc, int fr, int fq) const {
        const int row0 = u.pm * BM + wr * 64 + fr, col0 = u.pn * BM + wc * 32 + 8 * fq;
#pragma unroll
        for (int ai = 0; ai < 2; ++ai)
#pragma unroll
            for (int m = 0; m < 4; ++m) { const int row = row0 + ai * HALF + m * 16; const float r = row_rstd(part, row, fq);
                bf16_t* rowp = O + (size_t)row * ldc + col0;
#pragma unroll
                for (int bj = 0; bj < 2; ++bj) *(u32x4*)(rowp + bj * HALF) = pack8(acc[ai][bj][m][0] * r, acc[ai][bj][m][1] * r);
                asm volatile("" ::: "memory"); }
    }
};
template <int MODE = 0  > struct EpiSwigluT {
    static constexpr bool PERM = true, AFTER_DRAIN = false;
    bf16_t* O; int ldc; const float* part;
    __device__ __forceinline__ void operator()(const f32x4 (&acc)[2][2][4][2], const Unit& u, int wr, int wc, int fr, int fq) const {
        const int row0 = u.pm * BM + wr * 64 + fr, col0 = u.pn * HALF + wc * 32 + 8 * fq;
        if (MODE == 2) {
#pragma unroll
            for (int ai = 0; ai < 2; ++ai)
#pragma unroll
                for (int bj = 0; bj < 2; ++bj)
#pragma unroll
                    for (int m = 0; m < 4; ++m)
#pragma unroll
                        for (int n = 0; n < 2; ++n) asm volatile("" :: "v"(acc[ai][bj][m][n]));
            return; }
#pragma unroll
        for (int ai = 0; ai < 2; ++ai)
#pragma unroll
            for (int m = 0; m < 4; ++m) { const int row = row0 + ai * HALF + m * 16; const float r = row_rstd(part, row, fq);
                f32x4 o[2];
#pragma unroll
                for (int n = 0; n < 2; ++n) { const f32x4 g = acc[ai][0][m][n] * r, up = acc[ai][1][m][n] * r;
#pragma unroll
                    for (int i = 0; i < 4; ++i) o[n][i] = silu_f(g[i]) * up[i]; }
                const u32x4 pk = pack8(o[0], o[1]);
                if (MODE == 1) asm volatile("" :: "v"(pk)); else *(u32x4*)(O + (size_t)row * ldc + col0) = pk;
                asm volatile("" ::: "memory"); }
    }
};
typedef EpiSwigluT<0> EpiSwiglu;
__device__ __forceinline__ f32x4 bf2x_lo(unsigned a, unsigned b) { f32x4 r; r[0] = __uint_as_float(a << 16); r[1] = __uint_as_float(a & 0xffff0000u); r[2] = __uint_as_float(b << 16); r[3] = __uint_as_float(b & 0xffff0000u); return r; }
struct EpiResid {
    static constexpr bool PERM = true, AFTER_DRAIN = false;
    const bf16_t* base; bf16_t* ob; float* part; float scale;
    __device__ __forceinline__ void operator()(const f32x4 (&acc)[2][2][4][2], const Unit& u, int wr, int wc, int fr, int fq) const {
        const int row0 = u.pm * BM + wr * 64 + fr, col0 = u.pn * BM + wc * 32 + 8 * fq;
#pragma unroll
        for (int ai = 0; ai < 2; ++ai)
#pragma unroll
            for (int m = 0; m < 4; ++m) { const int row = row0 + ai * HALF + m * 16; const size_t off = (size_t)row * 1024 + col0; float ss = 0.f;
#pragma unroll
                for (int bj = 0; bj < 2; ++bj) { const u32x4 bw = *(const u32x4*)(base + off + bj * HALF);
                    const f32x4 h0 = bf2x_lo(bw.x, bw.y) + acc[ai][bj][m][0] * scale, h1 = bf2x_lo(bw.z, bw.w) + acc[ai][bj][m][1] * scale;
                    *(u32x4*)(ob + off + bj * HALF) = pack8(h0, h1);
                    ss += (h0[0] * h0[0] + h0[1] * h0[1]) + (h0[2] * h0[2] + h0[3] * h0[3]) + (h1[0] * h1[0] + h1[1] * h1[1]) + (h1[2] * h1[2] + h1[3] * h1[3]); }
                ss += __shfl_xor(ss, 16); ss += __shfl_xor(ss, 32);
                if (fq == 0) part[(size_t)row * 16 + u.pn * 4 + wc] = ss;
                asm volatile("" ::: "memory"); }
    }
};

template <class Epi, class Sched, bool ALIGN_EPI = false, bool SP2 = false>
__device__ __forceinline__ void gemm_phase(PG8_LAS unsigned char* lds, const Gemm g, const Sched& S, const Epi& E) {
    const int tid = threadIdx.x, wid = __builtin_amdgcn_readfirstlane(tid >> 6), lane = tid & 63, wr = wid >> 2, wc = wid & 3, fr = lane & 15, fq = lane >> 4;
    const int K = g.K, nt = K / BK;
    unsigned voffA[2], voffB[2];
#pragma unroll
    for (int i = 0; i < 2; ++i) { int R, C; stage_rc(tid * 16 + i * 8192, R, C); const int Rb = Epi::PERM ? ((R & ~31) + perm32(R & 31)) : R;
        voffA[i] = (unsigned)(R * K + C) * 2u; voffB[i] = (unsigned)(Rb * K + C) * 2u; }
    const size_t kstep = (size_t)(BK * 2);
    const size_t hstep = (size_t)HALF * K * 2;
    const size_t tstep = 2 * hstep;
    const unsigned ldsw = (unsigned)wid * 1024u;
    const int aoff = lds_byte(wr * 64 + fr, fq * 8), boff = lds_byte(wc * 32 + fr, fq * 8);
#define PG8_SA(b, h) (((b) * 2 + (h)) * HTB)
#define PG8_SB(b, h) ((4 + (b) * 2 + (h)) * HTB)
#define PG8_STAGE(bufoff, gbase, voff) do { _Pragma("unroll") for (int _i = 0; _i < 2; ++_i) \
        __builtin_amdgcn_global_load_lds((const unsigned*)((const char*)(gbase) + (voff)[_i]), (PG8_LAS unsigned*)(lds + (bufoff) + ldsw + _i * 8192), 16, 0, 0); } while (0)
#define PG8_LDA(dst, b, h) do { _Pragma("unroll") for (int m = 0; m < 4; ++m) _Pragma("unroll") for (int k = 0; k < 2; ++k) dst[m][k] = *(const PG8_LAS bf16x8*)(lds + PG8_SA(b, h) + aoff + m * 2048 + k * 1024); } while (0)
#define PG8_LDB(dst, b, h) do { _Pragma("unroll") for (int n = 0; n < 2; ++n) _Pragma("unroll") for (int k = 0; k < 2; ++k) dst[n][k] = *(const PG8_LAS bf16x8*)(lds + PG8_SB(b, h) + boff + n * 2048 + k * 1024); } while (0)
#define PG8_MMA(ai, bj, At, Bt) do { __builtin_amdgcn_s_setprio(1); _Pragma("unroll") for (int m = 0; m < 4; ++m) _Pragma("unroll") for (int n = 0; n < 2; ++n) _Pragma("unroll") for (int k = 0; k < 2; ++k) \
        acc[ai][bj][m][n] = __builtin_amdgcn_mfma_f32_16x16x32_bf16(Bt[n][k], At[m][k], acc[ai][bj][m][n], 0, 0, 0); __builtin_amdgcn_s_setprio(0); } while (0)
#define PG8_WAIT_V(n) asm volatile("s_waitcnt vmcnt(" #n ")" ::: "memory")
#define PG8_WAIT_L(n) asm volatile("s_waitcnt lgkmcnt(" #n ")" ::: "memory")
#define PG8_BAR __builtin_amdgcn_s_barrier()
#define PG8_SCHED __builtin_amdgcn_sched_barrier(0)
    Unit cur, nxt; int ui = 0;
    if (!S.next(0, cur)) return;
    f32x4 acc[2][2][4][2];
#pragma unroll
    for (int a = 0; a < 2; ++a)
#pragma unroll
        for (int b = 0; b < 2; ++b)
#pragma unroll
            for (int m = 0; m < 4; ++m)
#pragma unroll
                for (int n = 0; n < 2; ++n) acc[a][b][m][n] = (f32x4){0.f, 0.f, 0.f, 0.f};
    bf16x8 At[4][2], B0[2][2], B1[2][2];
    const char* cA = (const char*)g.A + (size_t)cur.pm * tstep; const char* cB = (const char*)g.Bt + (size_t)cur.pn * tstep;
    S.a_ready(cur);
    if constexpr (SP2) {
        PG8_STAGE(PG8_SB(0, 0), cB, voffB); PG8_STAGE(PG8_SB(0, 1), cB + hstep, voffB); PG8_STAGE(PG8_SA(0, 0), cA, voffA); PG8_STAGE(PG8_SA(0, 1), cA + hstep, voffA);
        if (wr == 1) PG8_BAR;
        PG8_WAIT_V(2); PG8_BAR;
        PG8_STAGE(PG8_SB(1, 0), cB + kstep, voffB); PG8_STAGE(PG8_SA(1, 0), cA + kstep, voffA); PG8_STAGE(PG8_SB(1, 1), cB + hstep + kstep, voffB);
        PG8_WAIT_V(6); PG8_BAR;
    } else {
        PG8_STAGE(PG8_SB(0, 0), cB, voffB); PG8_STAGE(PG8_SA(0, 0), cA, voffA); PG8_STAGE(PG8_SB(0, 1), cB + hstep, voffB); PG8_STAGE(PG8_SA(0, 1), cA + hstep, voffA);
        if (wr == 1) PG8_BAR;
        PG8_WAIT_V(4); PG8_BAR;
        PG8_STAGE(PG8_SB(1, 0), cB + kstep, voffB); PG8_STAGE(PG8_SA(1, 0), cA + kstep, voffA); PG8_STAGE(PG8_SB(1, 1), cB + hstep + kstep, voffB);
        PG8_WAIT_V(6); PG8_BAR;
    }
    for (;;) {
        const bool has_next = S.next(ui + 1, nxt);
        const char* nA = has_next ? (const char*)g.A + (size_t)nxt.pm * tstep : cA; const char* nB = has_next ? (const char*)g.Bt + (size_t)nxt.pn * tstep : cB;
        for (int t = 0; t < nt; t += 2) {
            const bool last = (t == nt - 2);
            const char* a1 = cA + (size_t)(t + 1) * kstep;
            const char* a2 = last ? nA : cA + (size_t)(t + 2) * kstep; const char* b2 = last ? nB : cB + (size_t)(t + 2) * kstep;
            const char* a3 = a2 + kstep; const char* b3 = b2 + kstep;
            if (last && has_next) S.a_ready(nxt);
            if constexpr (SP2) {
            PG8_LDB(B0, 0, 0); PG8_LDB(B1, 0, 1); PG8_SCHED; PG8_LDA(At, 0, 0); PG8_STAGE(PG8_SA(1, 1), a1 + hstep, voffA);
            PG8_WAIT_V(8); PG8_WAIT_L(0); PG8_BAR; PG8_MMA(0, 0, At, B0); PG8_MMA(0, 1, At, B1); PG8_BAR; PG8_SCHED;
            PG8_LDA(At, 0, 1); PG8_STAGE(PG8_SB(0, 0), b2, voffB); PG8_STAGE(PG8_SB(0, 1), b2 + hstep, voffB); PG8_STAGE(PG8_SA(0, 0), a2, voffA);
            PG8_WAIT_V(8); PG8_WAIT_L(0); PG8_BAR; PG8_MMA(1, 0, At, B0); PG8_MMA(1, 1, At, B1); PG8_BAR; PG8_SCHED;
            PG8_LDB(B0, 1, 0); PG8_LDB(B1, 1, 1); PG8_SCHED; PG8_LDA(At, 1, 0); PG8_STAGE(PG8_SA(0, 1), a2 + hstep, voffA);
            PG8_WAIT_V(8); PG8_WAIT_L(0); PG8_BAR; PG8_MMA(0, 0, At, B0); PG8_MMA(0, 1, At, B1); PG8_BAR; PG8_SCHED;
            PG8_LDA(At, 1, 1); PG8_STAGE(PG8_SB(1, 0), b3, voffB); PG8_STAGE(PG8_SB(1, 1), b3 + hstep, voffB); PG8_STAGE(PG8_SA(1, 0), a3, voffA);
            PG8_WAIT_V(8); PG8_WAIT_L(0); PG8_BAR; PG8_MMA(1, 0, At, B0); PG8_MMA(1, 1, At, B1); PG8_BAR; PG8_SCHED;
            } else {
            PG8_LDB(B0, 0, 0); PG8_SCHED; PG8_LDA(At, 0, 0); PG8_STAGE(PG8_SA(1, 1), a1 + hstep, voffA);
            PG8_WAIT_L(8); PG8_BAR; PG8_WAIT_L(0); PG8_MMA(0, 0, At, B0); PG8_BAR; PG8_SCHED;
            PG8_LDB(B1, 0, 1); PG8_STAGE(PG8_SB(0, 0), b2, voffB);
            PG8_BAR; PG8_WAIT_L(0); PG8_MMA(0, 1, At, B1); PG8_BAR;
            PG8_LDA(At, 0, 1); PG8_STAGE(PG8_SA(0, 0), a2, voffA);
            PG8_BAR; PG8_WAIT_L(0); PG8_MMA(1, 0, At, B0); PG8_BAR; PG8_SCHED;
            PG8_STAGE(PG8_SB(0, 1), b2 + hstep, voffB);
            PG8_WAIT_V(6); PG8_BAR; PG8_MMA(1, 1, At, B1); PG8_BAR;
            PG8_LDB(B0, 1, 0); PG8_SCHED; PG8_LDA(At, 1, 0); PG8_STAGE(PG8_SA(0, 1), a2 + hstep, voffA);
            PG8_WAIT_L(8); PG8_BAR; PG8_WAIT_L(0); PG8_MMA(0, 0, At, B0); PG8_BAR; PG8_SCHED;
            PG8_LDB(B1, 1, 1); PG8_STAGE(PG8_SB(1, 0), b3, voffB);
            PG8_BAR; PG8_WAIT_L(0); PG8_MMA(0, 1, At, B1); PG8_BAR;
            PG8_LDA(At, 1, 1); PG8_STAGE(PG8_SA(1, 0), a3, voffA);
            PG8_BAR; PG8_WAIT_L(0); PG8_MMA(1, 0, At, B0); PG8_BAR; PG8_SCHED;
            PG8_STAGE(PG8_SB(1, 1), b3 + hstep, voffB);
            PG8_WAIT_V(6); PG8_BAR; PG8_MMA(1, 1, At, B1); PG8_BAR;
            }
        }
        if constexpr (ALIGN_EPI) { if (wr == 0) PG8_BAR; }
        if constexpr (!Epi::AFTER_DRAIN) { E(acc, cur, wr, wc, fr, fq); S.done(cur); }
        if (!has_next) break;
#pragma unroll
        for (int a = 0; a < 2; ++a)
#pragma unroll
            for (int b = 0; b < 2; ++b)
#pragma unroll
                for (int m = 0; m < 4; ++m)
#pragma unroll
                    for (int n = 0; n < 2; ++n) acc[a][b][m][n] = (f32x4){0.f, 0.f, 0.f, 0.f};
        cur = nxt; cA = nA; cB = nB; ++ui;
        if constexpr (ALIGN_EPI) { if (wr == 1) PG8_BAR; }
    }
    PG8_WAIT_V(0);
    if constexpr (!ALIGN_EPI) { if (wr == 0) PG8_BAR; }
    PG8_BAR;
    if constexpr (Epi::AFTER_DRAIN) { E.fused(acc, cur, wr, wc, fr, fq, lds, wid, lane); S.done(cur); }
#undef PG8_SA
#undef PG8_SB
#undef PG8_STAGE
#undef PG8_LDA
#undef PG8_LDB
#undef PG8_MMA
#undef PG8_WAIT_V
#undef PG8_WAIT_L
#undef PG8_BAR
#undef PG8_SCHED
}
}

constexpr int NWAVES = 8;
constexpr int BATCH = 8, SEQ = 2048, DM = 1024, FF = 2816, M = BATCH * SEQ;
constexpr int AIN = 2304, RIN = 3584;
constexpr float SB_EXIT = -105.0f;

constexpr size_t MiB = 1u << 20;
constexpr size_t WS_CTL = 0, CTL_ZERO_BYTES = 1 * MiB;
constexpr size_t WS_WFIN = 2 * MiB;
constexpr size_t WS_WFOUT = 46 * MiB;
constexpr size_t WS_WAIN = 68 * MiB, WS_WAOUT = 73 * MiB, WS_WRIN = 75 * MiB, WS_WROUT = 82 * MiB;
constexpr size_t WS_PART = 84 * MiB;
constexpr size_t WS_DEC = 85 * MiB;
constexpr size_t WS_HB = 86 * MiB;
constexpr size_t WS_SB = WS_WFIN;
constexpr size_t WS_OB = 118 * MiB;
constexpr size_t WS_ACT = 150 * MiB;
constexpr size_t WS_ST = 262 * MiB;
constexpr size_t WS_END = 326 * MiB;
constexpr int CW_BAR = 4096;

constexpr int RING_OFF = 0, RING_BYTES = 131072;
constexpr int LDSCTL_OFF = RING_BYTES, MISC_OFF = LDSCTL_OFF + 320;
constexpr int LDS_BYTES = 147456;

#define GAS __attribute__((address_space(1)))
#define LAS __attribute__((address_space(3)))
typedef unsigned short bf16;
typedef unsigned v4u __attribute__((ext_vector_type(4)));
typedef float f32x4 __attribute__((ext_vector_type(4)));
typedef short bf16x8 __attribute__((ext_vector_type(8)));
typedef GAS unsigned gu32;
typedef GAS unsigned long long gu64;
#define RLX_AGENT __ATOMIC_RELAXED, __HIP_MEMORY_SCOPE_AGENT
#define LDS_WAIT() asm volatile("s_waitcnt lgkmcnt(0)" ::: "memory")
#define VM_WAIT() asm volatile("s_waitcnt vmcnt(0)" ::: "memory")
__device__ __forceinline__ unsigned long long rt() { return __builtin_amdgcn_s_memrealtime(); }
__device__ __forceinline__ unsigned f2bf(float f) { unsigned u = __builtin_bit_cast(unsigned, f); return (u + 0x7fffu + ((u >> 16) & 1u)) >> 16; }
__device__ __forceinline__ unsigned pk2(float lo, float hi) { return f2bf(lo) | (f2bf(hi) << 16); }

#define XB_TMO      128
#define XB_XCNT(j)  (256  + 64 * (j))
#define XB_XSUB(j)  (1280 + 64 * (j))
#define XB_XGEN(j)  (2304 + 64 * (j))
#define XB_TOP      3328
#define XB_TOPGEN   3392
#define XCD_BAR_WORDS 3456
#define XB_SPIN_CAP (1u << 18)

__device__ __forceinline__ unsigned xb_ld(unsigned* p)              { return __hip_atomic_load(p, __ATOMIC_RELAXED, __HIP_MEMORY_SCOPE_AGENT); }
__device__ __forceinline__ unsigned xb_add(unsigned* p, unsigned v) { return __hip_atomic_fetch_add(p, v, __ATOMIC_RELAXED, __HIP_MEMORY_SCOPE_AGENT); }
__device__ __forceinline__ unsigned xb_xcc_id() { return (unsigned)__builtin_amdgcn_s_getreg((3 << 11) | 20) & 0xFu; }
#define XB_SPIN(cond, bar) do { unsigned _sp = 0; while (cond) { __builtin_amdgcn_s_sleep(1); \
    if ((++_sp & 255u) == 0u) { if (xb_ld(&(bar)[XB_TMO])) break; if (_sp > XB_SPIN_CAP) { atomicAdd(&(bar)[XB_TMO], 1u); break; } } } } while (0)

struct XcdBarrier {
    unsigned* bar; unsigned x;
    volatile LAS unsigned* st;
};

__device__ __forceinline__ XcdBarrier xcd_barrier_post(unsigned* bar, volatile LAS unsigned* st) {
    XcdBarrier b; b.bar = bar; b.x = xb_xcc_id(); b.st = st;
    if (threadIdx.x == 0) (void)xb_add(&bar[XB_XCNT(b.x)], 1u);
    return b;
}
__device__ __forceinline__ void xcd_barrier_complete(unsigned* bar, unsigned x, unsigned& nloc, unsigned& nx) {
    const unsigned G = gridDim.x * gridDim.y * gridDim.z;
    unsigned sum, cnt, mine, sp = 0u;
    for (;;) {
        sum = 0u; cnt = 0u; mine = 0u;
#pragma unroll
        for (unsigned j = 0; j < 16; ++j) { const unsigned c = xb_ld(&bar[XB_XCNT(j)]); sum += c; cnt += (c > 0u) ? 1u : 0u; mine = (j == x) ? c : mine; }
        if (sum == G) break;
        __builtin_amdgcn_s_sleep(1);
        if ((++sp & 255u) == 0u) { if (xb_ld(&bar[XB_TMO])) break; if (sp > XB_SPIN_CAP) { atomicAdd(&bar[XB_TMO], 1u); break; } }
    }
    nloc = mine > 0u ? mine : 1u; nx = cnt > 0u ? cnt : 1u;
}

__device__ __forceinline__ void xcd_barrier(const XcdBarrier& b) {
    asm volatile("s_waitcnt vmcnt(0)" ::: "memory");
    __syncthreads();
    if (threadIdx.x == 0) {
        unsigned* bar = b.bar;
        __builtin_amdgcn_s_waitcnt(0);
        unsigned nloc = b.st[0], nx = b.st[1];
        if (nloc == 0u) { xcd_barrier_complete(bar, b.x, nloc, nx); b.st[0] = nloc; b.st[1] = nx; }
        const unsigned old = xb_add(&bar[XB_XSUB(b.x)], 1u);
        const unsigned gen = old / nloc;
        if (old + 1u == (gen + 1u) * nloc) {
            __builtin_amdgcn_fence(__ATOMIC_RELEASE, "agent");
            asm volatile("s_waitcnt vmcnt(0)" ::: "memory");
            const unsigned og = xb_add(&bar[XB_TOP], 1u);
            const unsigned tg = og / nx;
            if (og + 1u == (tg + 1u) * nx) xb_add(&bar[XB_TOPGEN], 1u);
            else XB_SPIN(xb_ld(&bar[XB_TOPGEN]) == tg, bar);
            __builtin_amdgcn_fence(__ATOMIC_ACQUIRE, "agent");
            xb_add(&bar[XB_XGEN(b.x)], 1u);
            asm volatile("s_waitcnt vmcnt(0)" ::: "memory");
        } else {
            XB_SPIN(xb_ld(&bar[XB_XGEN(b.x)]) == gen, bar);
            __builtin_amdgcn_fence(__ATOMIC_ACQUIRE, "agent");
            asm volatile("s_waitcnt vmcnt(0)" ::: "memory");
        }
    }
    __syncthreads();
}


typedef float f32x16 __attribute__((ext_vector_type(16)));
typedef unsigned u32x2v __attribute__((ext_vector_type(2)));
__device__ __forceinline__ float bf2f(unsigned short v) { return __uint_as_float((unsigned)v << 16); }
__device__ __forceinline__ int crow(int r, int hi) { return (r & 3) + 8 * (r >> 2) + 4 * hi; }
__device__ __forceinline__ int swap23(int k) { return (k & ~12) | ((k & 4) << 1) | ((k & 8) >> 1); }
#define MFMA32(a, b, c) __builtin_amdgcn_mfma_f32_32x32x16_bf16((a), (b), (c), 0, 0, 0)
__device__ __forceinline__ bf16x8 packf8(float a0, float a1, float a2, float a3, float a4, float a5, float a6, float a7) {
    v4u w; w.x = pg8::cvt_pk_bf16(a0, a1); w.y = pg8::cvt_pk_bf16(a2, a3); w.z = pg8::cvt_pk_bf16(a4, a5); w.w = pg8::cvt_pk_bf16(a6, a7); return __builtin_bit_cast(bf16x8, w); }
__device__ __forceinline__ float wave_sum(float v) {
#pragma unroll
    for (int o = 1; o < 64; o <<= 1) v += __shfl_xor(v, o);
    return v;
}

__device__ __forceinline__ void p0_item(const float* W, int K, int N, bf16* WT, const float* gain, bool swg, LAS float* scr, int item, int lane) {
    const int nblk = N / 32, kb = item / nblk, nb = item % nblk, k0 = 64 * kb, n0 = 32 * nb;
    int sn0 = n0; if (swg) { const int pn = n0 >> 8, bj = (n0 >> 7) & 1, x0 = n0 & 127; sn0 = bj * FF + pn * 128 + x0; }
    const float gl = gain ? gain[k0 + lane] : 1.0f;
    float wv[32];
#pragma unroll
    for (int i = 0; i < 32; ++i) wv[i] = W[(size_t)(k0 + 2 * i + (lane >> 5)) * N + sn0 + (lane & 31)];
#pragma unroll
    for (int i = 0; i < 32; ++i) { const int kk = 2 * i + (lane >> 5); scr[kk * 33 + (lane & 31)] = wv[i] * __shfl(gl, kk); }
    LDS_WAIT(); asm volatile("" ::: "memory");
    const int c = lane & 7;
#pragma unroll
    for (int j = 0; j < 4; ++j) { const int n = (lane >> 3) + 8 * j; const LAS float* s = scr + (8 * c) * 33 + n;
        v4u o; o.x = pk2(s[0 * 33], s[1 * 33]); o.y = pk2(s[2 * 33], s[3 * 33]); o.z = pk2(s[4 * 33], s[5 * 33]); o.w = pk2(s[6 * 33], s[7 * 33]);
        *(GAS v4u*)(WT + (size_t)(n0 + n) * K + k0 + 8 * c) = o; }
    LDS_WAIT(); asm volatile("" ::: "memory");
}

struct Ptrs {
    const float *x, *norm_g, *ffn_w_in, *ffn_w_out, *attn_w_in, *attn_sinks, *attn_w_out, *rec_w_in, *lb_logits, *hgrn_norm_g, *conv_w, *rec_w_out, *final_g;
    float* out; unsigned char* ws;
};

constexpr int I_FIN = (DM / 64) * (2 * FF / 32), I_FOUT = (FF / 64) * (DM / 32), I_AIN = (DM / 64) * (AIN / 32), I_O = (DM / 64) * (DM / 32), I_RIN = (DM / 64) * (RIN / 32);
__host__ __device__ constexpr int conv_items_of(int id) { return id < 0 ? 0 : id < 4 ? I_FIN : id < 8 ? I_FOUT : id == 8 ? I_AIN : id == 10 ? I_RIN : I_O; }
__device__ __forceinline__ void conv_item(const Ptrs& P, int id, int r, LAS float* scr, int lane) {
    unsigned char* ws = P.ws;
    if (id < 4) { const int w = id, l = w >> 1, j = w & 1; p0_item(P.ffn_w_in + (size_t)w * DM * 2 * FF, DM, 2 * FF, (bf16*)(ws + WS_WFIN) + (size_t)w * 2 * FF * DM, P.norm_g + (l * 3 + (j ? 2 : 0)) * DM, true, scr, r, lane); }
    else if (id < 8) { const int w = id - 4; p0_item(P.ffn_w_out + (size_t)w * FF * DM, FF, DM, (bf16*)(ws + WS_WFOUT) + (size_t)w * DM * FF, nullptr, false, scr, r, lane); }
    else if (id == 8) p0_item(P.attn_w_in, DM, AIN, (bf16*)(ws + WS_WAIN), P.norm_g + (0 * 3 + 1) * DM, false, scr, r, lane);
    else if (id == 9) p0_item(P.attn_w_out, DM, DM, (bf16*)(ws + WS_WAOUT), nullptr, false, scr, r, lane);
    else if (id == 10) p0_item(P.rec_w_in, DM, RIN, (bf16*)(ws + WS_WRIN), P.norm_g + (1 * 3 + 1) * DM, false, scr, r, lane);
    else p0_item(P.rec_w_out, DM, DM, (bf16*)(ws + WS_WROUT), nullptr, false, scr, r, lane);
}
template <int A, int B, int C> __device__ __forceinline__ void convert_stage(const Ptrs& P, LAS unsigned char* lds, int wave, int lane, int gwi, int ngw) {
    LAS float* scr = (LAS float*)(lds + RING_OFF + wave * 16384);
    constexpr int nA = conv_items_of(A), nB = conv_items_of(B), nC = conv_items_of(C);
    for (int it = gwi; it < nA + nB + nC; it += ngw) {
        if (it < nA) conv_item(P, A, it, scr, lane);
        else if (it < nA + nB) conv_item(P, B, it - nA, scr, lane);
        else conv_item(P, C, it - nA - nB, scr, lane);
    }
}
template <int A, int B, int C> __device__ __forceinline__ void convert_in_slack(const Ptrs& P, LAS unsigned char* lds, int wave, int lane, int nwg) {
    const int G = gridDim.x, rem = nwg % G, c = blockIdx.x;
    if (rem == 0) { convert_stage<A, B, C>(P, lds, wave, lane, c * NWAVES + wave, G * NWAVES); __syncthreads(); }
    else if (c >= rem) { convert_stage<A, B, C>(P, lds, wave, lane, (c - rem) * NWAVES + wave, (G - rem) * NWAVES); __syncthreads(); }
}

__device__ __forceinline__ void p0_prologue(const Ptrs& P, LAS unsigned char* lds, int wave, int lane) {
    const int gw = blockIdx.x * NWAVES + wave, NGW = gridDim.x * NWAVES;
    unsigned char* ws = P.ws;
    convert_stage<0, -1, -1>(P, lds, wave, lane, gw, NGW);
    bf16* hb = (bf16*)(ws + WS_HB); float* part = (float*)(ws + WS_PART);
    for (int m = gw; m < M; m += NGW) {
        const GAS f32x4* xr = (const GAS f32x4*)(P.x + (size_t)m * DM) + lane;
        f32x4 v[4]; float s = 0.f;
#pragma unroll
        for (int j = 0; j < 4; ++j) { v[j] = xr[64 * j]; s += (v[j].x * v[j].x + v[j].y * v[j].y) + (v[j].z * v[j].z + v[j].w * v[j].w); }
        s = wave_sum(s);
        GAS unsigned long long* o8 = (GAS unsigned long long*)(hb + (size_t)m * DM) + lane;
#pragma unroll
        for (int j = 0; j < 4; ++j) o8[64 * j] = (unsigned long long)pk2(v[j].x, v[j].y) | ((unsigned long long)pk2(v[j].z, v[j].w) << 32);
        if (lane < 16) part[(size_t)m * 16 + lane] = lane == 0 ? s : 0.f;
    }
}

__device__ __forceinline__ void final_norm(const Ptrs& P, int wave, int lane) {
    const int gw = blockIdx.x * NWAVES + wave, NGW = gridDim.x * NWAVES;
    const bf16* hb = (const bf16*)(P.ws + WS_HB);
    f32x4 g[4];
#pragma unroll
    for (int j = 0; j < 4; ++j) g[j] = ((const f32x4*)P.final_g)[2 * lane + (j & 1) + 128 * (j >> 1)];
    for (int m = gw; m < M; m += NGW) {
        const v4u* hr = (const v4u*)(hb + (size_t)m * DM) + lane;
        f32x4 v[4]; float s = 0.f;
#pragma unroll
        for (int jj = 0; jj < 2; ++jj) { const v4u w = hr[64 * jj]; v[2 * jj] = pg8::bf2x_lo(w.x, w.y); v[2 * jj + 1] = pg8::bf2x_lo(w.z, w.w); }
#pragma unroll
        for (int j = 0; j < 4; ++j) s += (v[j].x * v[j].x + v[j].y * v[j].y) + (v[j].z * v[j].z + v[j].w * v[j].w);
        const float r = 1.0f / sqrtf(wave_sum(s) * (1.0f / DM) + pg8::RMS_EPS);
        GAS f32x4* orow = (GAS f32x4*)(P.out + (size_t)m * DM);
#pragma unroll
        for (int j = 0; j < 4; ++j) orow[2 * lane + (j & 1) + 128 * (j >> 1)] = v[j] * r * g[j];
    }
}

constexpr int VT_BYTES = 4096;
constexpr int OTSTR = 144;
__device__ __forceinline__ void load_v(const bf16* vsrc, int pitch, int lane, bf16x8 (&v)[4]) {
#pragma unroll
    for (int i = 0; i < 4; ++i) v[i] = *(const bf16x8*)(vsrc + (size_t)(i * 8 + (lane >> 3)) * pitch + 8 * (lane & 7));
}
__device__ __forceinline__ void stage_vt(LAS unsigned char* vt, int lane, const bf16x8 (&v)[4]) {
    const int c = lane & 7;
#pragma unroll
    for (int i = 0; i < 4; ++i) *(LAS bf16x8*)(vt + (c >> 2) * 2048 + (i * 8 + (lane >> 3)) * 64 + (c & 3) * 16) = v[i];
}
typedef short v4i16_t __attribute__((ext_vector_type(4)));
__device__ __forceinline__ bf16x8 read_vt(const LAS unsigned char* vt, int dhalf, int s2, int lane) {
    const int h = lane >> 5;
    const LAS unsigned char* p = vt + dhalf * 2048 + (16 * s2 + 4 * h + ((lane & 15) >> 2)) * 64 + ((lane >> 4) & 1) * 32 + (lane & 3) * 8;
    const v4i16_t lo = __builtin_amdgcn_ds_read_tr16_b64_v4i16((LAS v4i16_t*)p), hi = __builtin_amdgcn_ds_read_tr16_b64_v4i16((LAS v4i16_t*)(p + 512));
    return (bf16x8){lo[0], lo[1], lo[2], lo[3], hi[0], hi[1], hi[2], hi[3]};
}
__device__ __forceinline__ void load_k(const bf16* kp, bf16x8 (&k)[4]) {
#pragma unroll
    for (int st = 0; st < 4; ++st) k[st] = *(const bf16x8*)(kp + 16 * st);
}
__device__ __forceinline__ void store_o(LAS unsigned char* ot, bf16* op  , const f32x16& O0, const f32x16& O1, int lane) {
    const int c = lane & 31, hi = lane >> 5;
#pragma unroll
    for (int r = 0; r < 16; ++r) { LAS unsigned char* p = ot + crow(r, hi) * OTSTR + 2 * c; *(LAS unsigned short*)p = (unsigned short)f2bf(O0[r]); *(LAS unsigned short*)(p + 64) = (unsigned short)f2bf(O1[r]); }
#pragma unroll
    for (int i = 0; i < 4; ++i) { const int row = i * 8 + (lane >> 3), ch = lane & 7; *(bf16x8*)(op + (size_t)row * DM + 8 * ch) = *(const LAS bf16x8*)(ot + row * OTSTR + 16 * ch); }
}

__device__ __forceinline__ void swa_unit(const bf16* qkv, bf16* obuf, const float* sinks, int b, int hq, int qb, LAS unsigned char* vt, int lane) {
    const int c = lane & 31, hi = lane >> 5, kvh = hq >> 2;
    const size_t rowbase = (size_t)b * SEQ;
    const bf16* qp = qkv + (rowbase + qb * 32 + c) * AIN + hq * 64 + 8 * hi;
    bf16x8 qf[4]; load_k(qp, qf);
    bf16x8 kf[5][4];
#pragma unroll
    for (int i = 0; i < 5; ++i) { const int kb = qb - 4 + i; if (kb >= 0) load_k(qkv + (rowbase + kb * 32 + c) * AIN + 512 + kvh * 64 + 8 * hi, kf[i]); }
    const bf16* vbase = qkv + rowbase * AIN + 640 + kvh * 64;
    const int i0 = qb >= 4 ? 0 : 4 - qb;
    bf16x8 vcur[4], vnext[4];
    load_v(vbase + (size_t)(qb - 4 + i0) * 32 * AIN, AIN, lane, vcur);
    const float slope = exp2f(-(float)(hq + 1)), sink = sinks[hq];
    f32x16 X[5]; float mx = -INFINITY;
#pragma unroll
    for (int i = 0; i < 5; ++i) { const int kb = qb - 4 + i;
        f32x16 a;
#pragma unroll
        for (int r = 0; r < 16; ++r) a[r] = 0.f;
        if (kb >= 0) {
#pragma unroll
            for (int st = 0; st < 4; ++st) a = MFMA32(kf[i][st], qf[st], a);
#pragma unroll
            for (int r = 0; r < 16; ++r) { const int dist = (qb * 32 + c) - (kb * 32 + crow(r, hi)); const bool valid = dist >= 0 && dist < 128;
                const float s = valid ? a[r] * 0.125f - slope * (float)dist : -INFINITY; a[r] = s; mx = fmaxf(mx, s); }
        } else {
#pragma unroll
            for (int r = 0; r < 16; ++r) a[r] = -INFINITY;
        }
        X[i] = a; }
    mx = fmaxf(mx, __shfl_xor(mx, 32)); mx = fmaxf(mx, sink);
    float sum = 0.f;
#pragma unroll
    for (int i = 0; i < 5; ++i)
#pragma unroll
        for (int r = 0; r < 16; ++r) { const float p = __expf(X[i][r] - mx); X[i][r] = p; sum += p; }
    sum += __shfl_xor(sum, 32);
    const float inv = 1.0f / (sum + __expf(sink - mx));
    f32x16 O0, O1;
#pragma unroll
    for (int r = 0; r < 16; ++r) { O0[r] = 0.f; O1[r] = 0.f; }
#pragma unroll
    for (int i = 0; i < 5; ++i) { const int kb = qb - 4 + i;
        if (kb >= 0) {
            if (i < 4) load_v(vbase + (size_t)(kb + 1) * 32 * AIN, AIN, lane, vnext);
            stage_vt(vt, lane, vcur);
#pragma unroll
            for (int s2 = 0; s2 < 2; ++s2) {
                const bf16x8 pf = packf8(X[i][8 * s2 + 0] * inv, X[i][8 * s2 + 1] * inv, X[i][8 * s2 + 2] * inv, X[i][8 * s2 + 3] * inv, X[i][8 * s2 + 4] * inv, X[i][8 * s2 + 5] * inv, X[i][8 * s2 + 6] * inv, X[i][8 * s2 + 7] * inv);
                O0 = MFMA32(pf, read_vt(vt, 0, s2, lane), O0); O1 = MFMA32(pf, read_vt(vt, 1, s2, lane), O1); }
            if (i < 4) {
#pragma unroll
                for (int k = 0; k < 4; ++k) vcur[k] = vnext[k]; }
        } }
    store_o(vt + VT_BYTES, obuf + (rowbase + qb * 32) * DM + hq * 64, O0, O1, lane);
}

__device__ __forceinline__ void sb_unit(const bf16* qkv, bf16* obuf, int b, int h, int qb, LAS unsigned char* vt, int lane) {
    const int c = lane & 31, hi = lane >> 5, t = qb * 32 + c;
    const size_t rowbase = (size_t)b * SEQ;
    bf16x8 qf[4]; load_k(qkv + (rowbase + t) * AIN + 768 + h * 64 + 8 * hi, qf);
    const bf16* kbase = qkv + (rowbase + c) * AIN + 1280 + h * 64 + 8 * hi;
    const bf16* vbase = qkv + rowbase * AIN + 1792 + h * 64;
    bf16x8 kf[4], vf[4], kn[4], vn[4];
    load_k(kbase + (size_t)qb * 32 * AIN, kf); load_v(vbase + (size_t)qb * 32 * AIN, AIN, lane, vf);
    float carry = 0.f;
    f32x16 O0, O1;
#pragma unroll
    for (int r = 0; r < 16; ++r) { O0[r] = 0.f; O1[r] = 0.f; }
    for (int kb = qb; kb >= 0; --kb) {
        { const int kbn = kb > 0 ? kb - 1 : 0; load_k(kbase + (size_t)kbn * 32 * AIN, kn); load_v(vbase + (size_t)kbn * 32 * AIN, AIN, lane, vn); }
        f32x16 a;
#pragma unroll
        for (int r = 0; r < 16; ++r) a[r] = 0.f;
#pragma unroll
        for (int st = 0; st < 4; ++st) a = MFMA32(kf[st], qf[st], a);
        float lk[16], lsg[16];
#pragma unroll
        for (int r = 0; r < 16; ++r) { const float z = a[r] * 0.125f; const bool causal = (kb * 32 + crow(r, hi)) < t;
            const float sp = fmaxf(z, 0.f) + __logf(1.0f + __expf(-fabsf(z)));
            lk[r] = causal ? -sp : 0.f; lsg[r] = z - sp; }
        float G[4], Gp[4];
#pragma unroll
        for (int g = 0; g < 4; ++g) { G[g] = (lk[4 * g] + lk[4 * g + 1]) + (lk[4 * g + 2] + lk[4 * g + 3]); Gp[g] = __shfl_xor(G[g], 32); }
        float tail = 0.f; f32x16 w;
#pragma unroll
        for (int g = 3; g >= 0; --g) { const float base = carry + tail + (hi == 0 ? Gp[g] : 0.f); float run = 0.f;
#pragma unroll
            for (int i = 3; i >= 0; --i) { const int r = 4 * g + i; const bool causal = (kb * 32 + crow(r, hi)) < t;
                w[r] = causal ? __expf(lsg[r] + base + run) : 0.f; run += lk[r]; }
            tail += G[g] + Gp[g]; }
        carry += tail;
        stage_vt(vt, lane, vf);
#pragma unroll
        for (int s2 = 0; s2 < 2; ++s2) {
            const bf16x8 pf = packf8(w[8 * s2 + 0], w[8 * s2 + 1], w[8 * s2 + 2], w[8 * s2 + 3], w[8 * s2 + 4], w[8 * s2 + 5], w[8 * s2 + 6], w[8 * s2 + 7]);
            O0 = MFMA32(pf, read_vt(vt, 0, s2, lane), O0); O1 = MFMA32(pf, read_vt(vt, 1, s2, lane), O1); }
        if (__all(carry < SB_EXIT)) break;
#pragma unroll
        for (int k = 0; k < 4; ++k) { kf[k] = kn[k]; vf[k] = vn[k]; }
    }
    store_o(vt + VT_BYTES, obuf + (rowbase + qb * 32) * DM + 512 + h * 64, O0, O1, lane);
}

__device__ __forceinline__ void attn_phase(const Ptrs& P, LAS unsigned char* lds, int wave, int lane) {
    const bf16* qkv = (const bf16*)(P.ws + WS_ACT); bf16* obuf = (bf16*)(P.ws + WS_OB);
    LAS unsigned char* vt = lds + RING_OFF + wave * 10240;
    const int gw = blockIdx.x * NWAVES + wave, NGW = gridDim.x * NWAVES;
    constexpr int NU = BATCH * 8 * (SEQ / 32);
    for (int u = gw; u < 2 * NU; u += NGW) {
        if (u < NU) { const int qb = (SEQ / 32 - 1) - (u >> 6), bh = u & 63; sb_unit(qkv, obuf, bh >> 3, bh & 7, qb, vt, lane); }
        else { const int v = u - NU, qb = v >> 6, bh = v & 63; swa_unit(qkv, obuf, P.attn_sinks, bh >> 3, bh & 7, qb, vt, lane); }
    }
}

constexpr int KSTR = 144;
constexpr int QSTR = 272;
constexpr int OSTR = 132;
constexpr int L_TOT = 0, L_GL = 2048, L_KS = L_GL + 64 * OSTR * 4, L_VT = L_KS + 128 * KSTR, L_RZ = L_VT + 128 * KSTR, L_RV = L_RZ + 64 * QSTR, L_A_END = L_RV + 64 * QSTR;
constexpr int L_QI = L_KS, L_QX = L_QI + 64 * QSTR, L_KX = L_QX + 64 * QSTR, L_VT2 = L_KX + 64 * QSTR, L_OF = L_GL, L_RS = L_VT2 + 128 * KSTR, L_C_END = L_RS + 256;
static_assert(L_A_END <= RING_BYTES && L_C_END <= RING_BYTES, "HGRN2 LDS map");

__device__ __forceinline__ float hgrn_lb(const float* logits, int col) {
    const float l0 = logits[col], l1 = logits[512 + col]; return 1.0f / (1.0f + __expf(l0 - l1));
}
__device__ __forceinline__ void tile_load(const bf16* src, int tid, bf16x8 (&r)[2]) {
#pragma unroll
    for (int i = 0; i < 2; ++i) { const int ci = tid + 512 * i; r[i] = *(const bf16x8*)(src + (size_t)(ci >> 4) * RIN + 8 * (ci & 15)); }
}
__device__ __forceinline__ void tile_to_lds(LAS unsigned char* dst, int tid, const bf16x8 (&r)[2]) {
#pragma unroll
    for (int i = 0; i < 2; ++i) { const int ci = tid + 512 * i; *(LAS bf16x8*)(dst + (ci >> 4) * QSTR + 16 * (ci & 15)) = r[i]; }
}
__device__ __forceinline__ float lds_bf(const LAS unsigned char* img, int t, int d) { return bf2f(*(const LAS unsigned short*)(img + t * QSTR + 2 * d)); }
__device__ __forceinline__ void hgrn_gates(const LAS unsigned char* rz, int d, int tq, float lbv, LAS float* tot, LAS float* GL) {
    float cum = 0.f;
#pragma unroll
    for (int j = 0; j < 16; ++j) { const float z = lds_bf(rz, tq * 16 + j, d);
        const float sg = 1.0f / (1.0f + __expf(-z)); cum += __logf(lbv + (1.0f - lbv) * sg); GL[(tq * 16 + j) * 128 + d] = cum; }
    tot[tq * 128 + d] = cum;
    __syncthreads();
}

__device__ __forceinline__ void rec_pass_a(const Ptrs& P, LAS unsigned char* lds, int wave, int lane) {
    const bf16* qkv = (const bf16*)(P.ws + WS_ACT); bf16* obuf = (bf16*)(P.ws + WS_OB);
    bf16* st = (bf16*)(P.ws + WS_ST); float* dec = (float*)(P.ws + WS_DEC);
    const int tid = threadIdx.x, d = tid & 127, tq = tid >> 7, c = lane & 31, hi = lane >> 5, G = gridDim.x;
    LAS float* tot = (LAS float*)(lds + L_TOT); LAS float* GL = (LAS float*)(lds + L_GL);
    bf16x8 pz[2], pv[2];
    int u = blockIdx.x;
    if (u < 1024) { const bf16* src = qkv + ((size_t)(u >> 7) * SEQ + (u & 31) * 64) * RIN + ((u >> 5) & 3) * 128; tile_load(src + 512, tid, pz); tile_load(src + 1024, tid, pv); }
    for (; u < 1024; u += G) {
        const int hh = (u >> 5) & 3;
        tile_to_lds(lds + L_RZ, tid, pz); tile_to_lds(lds + L_RV, tid, pv);
        { const int un = u + G; if (un < 1024) { const bf16* src = qkv + ((size_t)(un >> 7) * SEQ + (un & 31) * 64) * RIN + ((un >> 5) & 3) * 128; tile_load(src + 512, tid, pz); tile_load(src + 1024, tid, pv); } }
        __syncthreads();
        const float lbv = hgrn_lb(P.lb_logits, hh * 128 + d);
        hgrn_gates(lds + L_RZ, d, tq, lbv, tot, GL);
        float off = 0.f;
#pragma unroll
        for (int q = 0; q < 3; ++q) off += (q < tq) ? tot[q * 128 + d] : 0.f;
        const float glast = tot[d] + tot[128 + d] + tot[256 + d] + tot[384 + d];
        if (tq == 0) dec[u * 128 + d] = __expf(glast);
#pragma unroll
        for (int grp = 0; grp < 2; ++grp) {
            float ks[8]; bf16x8 vv;
#pragma unroll
            for (int j = 0; j < 8; ++j) { const int t = tq * 16 + grp * 8 + j; const float z = lds_bf(lds + L_RZ, t, d), g = GL[t * 128 + d] + off;
                ks[j] = (1.0f - lbv) / (1.0f + __expf(z)) * __expf(glast - g); vv[j] = *(const LAS short*)(lds + L_RV + t * QSTR + 2 * d); }
            *(LAS bf16x8*)(lds + L_KS + d * KSTR + tq * 32 + grp * 16) = packf8(ks[0], ks[1], ks[2], ks[3], ks[4], ks[5], ks[6], ks[7]);
            *(LAS bf16x8*)(lds + L_VT + d * KSTR + tq * 32 + grp * 16) = vv;
        }
        __syncthreads();
        const int eb = wave >> 1;
        LAS unsigned char* img = lds + (wave < 4 ? L_GL + wave * 4608 : L_RZ + (wave - 4) * 4608);
#pragma unroll
        for (int dbi = 0; dbi < 2; ++dbi) { const int db = 2 * (wave & 1) + dbi;
            f32x16 acc;
#pragma unroll
            for (int r = 0; r < 16; ++r) acc[r] = 0.f;
#pragma unroll
            for (int s = 0; s < 4; ++s) acc = MFMA32(*(const LAS bf16x8*)(lds + L_VT + (eb * 32 + c) * KSTR + 32 * s + 16 * hi), *(const LAS bf16x8*)(lds + L_KS + (db * 32 + c) * KSTR + 32 * s + 16 * hi), acc);
#pragma unroll
            for (int r = 0; r < 16; ++r) *(LAS unsigned short*)(img + crow(r, hi) * 144 + dbi * 64 + 2 * c) = (unsigned short)f2bf(acc[r]); }
        { bf16* sp = st + ((size_t)u * 128 + eb * 32) * 128 + (wave & 1) * 64;
#pragma unroll
            for (int i = 0; i < 4; ++i) { const int q = lane + 64 * i, row = q >> 3, chk = q & 7; *(bf16x8*)(sp + (size_t)row * 128 + 8 * chk) = *(const LAS bf16x8*)(img + row * 144 + 16 * chk); } }
        __syncthreads();
    }
    const int gid = blockIdx.x * (NWAVES * 64) + tid, NT = gridDim.x * NWAVES * 64;
#pragma unroll 2
    for (int it = gid; it < M * 64; it += NT) {
        const int row = it >> 6, c8 = (it & 63) * 8, t = row & (SEQ - 1);
        const bf16* rp = qkv + (size_t)row * RIN; const bf16* rp1 = t >= 1 ? rp - RIN : rp; const bf16* rp2 = t >= 2 ? rp - 2 * RIN : rp;
        const float m1 = t >= 1 ? 1.f : 0.f, m2 = t >= 2 ? 1.f : 0.f;
        const bf16x8 gb = *(const bf16x8*)(rp + 2048 + c8), gc0 = *(const bf16x8*)(rp + 2560 + c8), u0 = *(const bf16x8*)(rp + 3072 + c8);
        const bf16x8 gc1 = *(const bf16x8*)(rp1 + 2560 + c8), u1 = *(const bf16x8*)(rp1 + 3072 + c8), gc2 = *(const bf16x8*)(rp2 + 2560 + c8), u2 = *(const bf16x8*)(rp2 + 3072 + c8);
        const f32x4 w0a = *(const f32x4*)(P.conv_w + c8), w0b = *(const f32x4*)(P.conv_w + c8 + 4), w1a = *(const f32x4*)(P.conv_w + 512 + c8), w1b = *(const f32x4*)(P.conv_w + 512 + c8 + 4), w2a = *(const f32x4*)(P.conv_w + 1024 + c8), w2b = *(const f32x4*)(P.conv_w + 1024 + c8 + 4);
        float o[8];
#pragma unroll
        for (int j = 0; j < 8; ++j) { const float w0 = j < 4 ? w0a[j & 3] : w0b[j & 3], w1 = j < 4 ? w1a[j & 3] : w1b[j & 3], w2 = j < 4 ? w2a[j & 3] : w2b[j & 3];
            const float x0 = bf2f((unsigned short)gc0[j]) * bf2f((unsigned short)u0[j]), x1 = m1 * bf2f((unsigned short)gc1[j]) * bf2f((unsigned short)u1[j]), x2 = m2 * bf2f((unsigned short)gc2[j]) * bf2f((unsigned short)u2[j]);
            o[j] = bf2f((unsigned short)gb[j]) * (w0 * x2 + w1 * x1 + w2 * x0); }
        *(bf16x8*)(obuf + (size_t)row * DM + 512 + c8) = packf8(o[0], o[1], o[2], o[3], o[4], o[5], o[6], o[7]);
    }
}

__device__ __forceinline__ void rec_pass_b(const Ptrs& P) {
    const bf16* st = (const bf16*)(P.ws + WS_ST); const float* dec = (const float*)(P.ws + WS_DEC); bf16* sb = (bf16*)(P.ws + WS_SB);
    const int gid = blockIdx.x * (NWAVES * 64) + threadIdx.x, NT = gridDim.x * NWAVES * 64;
    for (int x = gid; x < 32 * 4096; x += NT) {
        const int seq = x >> 12, ed = (x & 4095) * 4, d = ed & 127; f32x4 S = {0.f, 0.f, 0.f, 0.f};
#pragma unroll 1
        for (int half = 0; half < 2; ++half) {
            f32x4 kv[16], dc[16];
#pragma unroll
            for (int i = 0; i < 16; ++i) { const size_t u = (size_t)seq * 32 + half * 16 + i; { const u32x2v kw = *(const u32x2v*)(st + u * 16384 + ed); kv[i] = pg8::bf2x_lo(kw.x, kw.y); } dc[i] = *(const f32x4*)(dec + u * 128 + d); }
#pragma unroll
            for (int i = 0; i < 16; ++i) { const size_t u = (size_t)seq * 32 + half * 16 + i;
                u32x2v w; w.x = pg8::cvt_pk_bf16(S[0], S[1]); w.y = pg8::cvt_pk_bf16(S[2], S[3]); *(u32x2v*)(sb + u * 16384 + ed) = w;
                S = dc[i] * S + kv[i]; }
        }
    }
}

__device__ __forceinline__ void rec_pass_c(const Ptrs& P, LAS unsigned char* lds, int wave, int lane) {
    const bf16* qkv = (const bf16*)(P.ws + WS_ACT); bf16* obuf = (bf16*)(P.ws + WS_OB); const bf16* sb = (const bf16*)(P.ws + WS_SB);
    const int tid = threadIdx.x, d = tid & 127, tq = tid >> 7, c = lane & 31, hi = lane >> 5, G = gridDim.x;
    const int tb = wave & 1, eb = wave >> 1;
    LAS float* tot = (LAS float*)(lds + L_TOT); LAS float* GL = (LAS float*)(lds + L_GL); LAS float* OF = (LAS float*)(lds + L_OF); LAS float* RS = (LAS float*)(lds + L_RS);
    bf16x8 pq[2], pz[2], pv[2];
    int u = blockIdx.x;
    if (u < 1024) { const bf16* src = qkv + ((size_t)(u >> 7) * SEQ + (u & 31) * 64) * RIN + ((u >> 5) & 3) * 128; tile_load(src, tid, pq); tile_load(src + 512, tid, pz); tile_load(src + 1024, tid, pv); }
    for (; u < 1024; u += G) {
        const int b = u >> 7, hh = (u >> 5) & 3, ch = u & 31; const size_t row0 = (size_t)b * SEQ + ch * 64;
        tile_to_lds(lds + L_QI, tid, pq); tile_to_lds(lds + L_KX, tid, pz); tile_to_lds(lds + L_QX, tid, pv);
        bf16x8 sf[8], pg[2];
        { const bf16* sp = sb + ((size_t)u * 128 + eb * 32 + c) * 128 + 8 * hi;
#pragma unroll
            for (int s = 0; s < 8; ++s) sf[s] = *(const bf16x8*)(sp + 16 * s); }
        tile_load(qkv + row0 * RIN + 1536 + hh * 128, tid, pg);
        { const int un = u + G; if (un < 1024) { const bf16* src = qkv + ((size_t)(un >> 7) * SEQ + (un & 31) * 64) * RIN + ((un >> 5) & 3) * 128; tile_load(src, tid, pq); tile_load(src + 512, tid, pz); tile_load(src + 1024, tid, pv); } }
        __syncthreads();
        const float lbv = hgrn_lb(P.lb_logits, hh * 128 + d);
        hgrn_gates(lds + L_KX, d, tq, lbv, tot, GL);
        float off = 0.f;
#pragma unroll
        for (int q = 0; q < 3; ++q) off += (q < tq) ? tot[q * 128 + d] : 0.f;
        const float gref = tot[d] + tot[128 + d];
#pragma unroll
        for (int grp = 0; grp < 2; ++grp) { bf16x8 vv;
#pragma unroll
            for (int k = 0; k < 8; ++k) { const int j = (k & 3) + 8 * (k >> 2) + 4 * grp; vv[k] = *(const LAS short*)(lds + L_QX + (tq * 16 + j) * QSTR + 2 * d); }
            *(LAS bf16x8*)(lds + L_VT2 + d * KSTR + tq * 32 + grp * 16) = vv; }
#pragma unroll 4
        for (int j = 0; j < 16; ++j) { const int t = tq * 16 + j;
            const float qv = lds_bf(lds + L_QI, t, d), z = lds_bf(lds + L_KX, t, d), g = GL[t * 128 + d] + off, sq = pg8::silu_f(qv);
            const float kx = (1.0f - lbv) / (1.0f + __expf(z)) * __expf(fminf(gref - g, 80.f));
            *(LAS unsigned short*)(lds + L_QI + t * QSTR + 2 * d) = (unsigned short)f2bf(sq * __expf(g));
            *(LAS unsigned short*)(lds + L_QX + t * QSTR + 2 * d) = (unsigned short)f2bf(sq * __expf(fminf(g - gref, 80.f)));
            *(LAS unsigned short*)(lds + L_KX + t * QSTR + 2 * d) = (unsigned short)f2bf(kx); }
        __syncthreads();
        f32x16 acc;
#pragma unroll
        for (int r = 0; r < 16; ++r) acc[r] = 0.f;
#pragma unroll
        for (int s = 0; s < 8; ++s) acc = MFMA32(*(const LAS bf16x8*)(lds + L_QI + (tb * 32 + c) * QSTR + 32 * s + 16 * hi), sf[s], acc);
        for (int sbk = 0; sbk <= tb; ++sbk) {
            f32x16 X;
#pragma unroll
            for (int r = 0; r < 16; ++r) X[r] = 0.f;
#pragma unroll
            for (int s = 0; s < 8; ++s) X = MFMA32(*(const LAS bf16x8*)(lds + L_KX + (sbk * 32 + c) * QSTR + 32 * s + 16 * hi), *(const LAS bf16x8*)(lds + L_QX + (tb * 32 + c) * QSTR + 32 * s + 16 * hi), X);
#pragma unroll
            for (int r = 0; r < 16; ++r) X[r] = (sbk * 32 + crow(r, hi) <= tb * 32 + c) ? X[r] : 0.f;
#pragma unroll
            for (int s2 = 0; s2 < 2; ++s2) {
                const bf16x8 pf = packf8(X[8 * s2 + 0], X[8 * s2 + 1], X[8 * s2 + 2], X[8 * s2 + 3], X[8 * s2 + 4], X[8 * s2 + 5], X[8 * s2 + 6], X[8 * s2 + 7]);
                acc = MFMA32(pf, *(const LAS bf16x8*)(lds + L_VT2 + (eb * 32 + c) * KSTR + sbk * 64 + 32 * s2 + 16 * hi), acc); }
        }
#pragma unroll
        for (int r = 0; r < 16; ++r) OF[(tb * 32 + crow(r, hi)) * OSTR + eb * 32 + c] = acc[r];
        __syncthreads();
        { const int t = tid >> 3, pt = tid & 7; float ss = 0.f;
#pragma unroll
            for (int k = 0; k < 16; ++k) { const float v = OF[t * OSTR + pt * 16 + k]; ss += v * v; }
            ss += __shfl_xor(ss, 1); ss += __shfl_xor(ss, 2); ss += __shfl_xor(ss, 4);
            if (pt == 0) RS[t] = 1.0f / sqrtf(ss * (1.0f / 128.0f) + pg8::RMS_EPS); }
        __syncthreads();
#pragma unroll
        for (int i = 0; i < 2; ++i) { const int ci = tid + 512 * i, t = ci >> 4, e8 = 8 * (ci & 15);
            const f32x4 o0 = *(const LAS f32x4*)(OF + t * OSTR + e8), o1 = *(const LAS f32x4*)(OF + t * OSTR + e8 + 4);
            const f32x4 g0 = *(const f32x4*)(P.hgrn_norm_g + e8), g1 = *(const f32x4*)(P.hgrn_norm_g + e8 + 4); const float rs = RS[t];
            float o[8];
#pragma unroll
            for (int k = 0; k < 8; ++k) { const float gate = bf2f((unsigned short)pg[i][k]); o[k] = (k < 4 ? o0[k & 3] * g0[k & 3] : o1[k & 3] * g1[k & 3]) * rs * pg8::silu_f(gate); }
            *(bf16x8*)(obuf + (row0 + t) * DM + hh * 128 + e8) = packf8(o[0], o[1], o[2], o[3], o[4], o[5], o[6], o[7]); }
        __syncthreads();
    }
}

#ifndef STAGGER_TICKS
#define STAGGER_TICKS 800
#endif
__device__ __forceinline__ void stagger_delay(int nwg, int G, int c) {
    const int rem = nwg % G;
    if (rem == 0 || c < rem || STAGGER_TICKS == 0) return;
    const int j = ((c - rem) * 2) / (G - rem);
    const unsigned long long t0 = __builtin_amdgcn_s_memrealtime(), dt = (unsigned long long)(j + 1) * STAGGER_TICKS;
    while (__builtin_amdgcn_s_memrealtime() - t0 < dt) __builtin_amdgcn_s_sleep(32);
}

__device__ __forceinline__ void flat_barrier(unsigned* cnt, unsigned* tmo, volatile LAS unsigned* ep) {
    asm volatile("s_waitcnt vmcnt(0)" ::: "memory");
    __syncthreads();
    if (threadIdx.x == 0) {
        const unsigned e = ep[0]; ep[0] = e + 1u;
        __builtin_amdgcn_fence(__ATOMIC_RELEASE, "agent");
        asm volatile("s_waitcnt vmcnt(0)" ::: "memory");
        (void)__hip_atomic_fetch_add(cnt, 1u, __ATOMIC_RELAXED, __HIP_MEMORY_SCOPE_AGENT);
        const unsigned target = (e + 1u) * gridDim.x; unsigned sp = 0;
        while (xb_ld(cnt) < target) { __builtin_amdgcn_s_sleep(2); if ((++sp & 1023u) == 0u) { if (xb_ld(tmo)) break; if (sp > (1u << 20)) { atomicAdd(tmo, 1u); break; } } }
        __builtin_amdgcn_fence(__ATOMIC_ACQUIRE, "agent");
        asm volatile("s_waitcnt vmcnt(0)" ::: "memory");
    }
    __syncthreads();
}
#ifndef FLAT_BAR
#define FLAT_BAR 0
#endif
#if FLAT_BAR
#define GRID_BARRIER() flat_barrier((unsigned*)(ctl + CW_BAR + 64), (unsigned*)(ctl + CW_BAR + 128), MISC + 10)
#else
#define GRID_BARRIER() xcd_barrier(bar)
#endif

constexpr int N_PHASES = 18;
struct Args { Ptrs p; int ph_lo, ph_hi; };
__global__ void __launch_bounds__(NWAVES * 64, 2) trunk_fwd(Args args) {
    extern __shared__ __attribute__((aligned(16))) unsigned char lds_raw[];
    LAS unsigned char* lds = (LAS unsigned char*)lds_raw;
    volatile LAS unsigned* MISC = (volatile LAS unsigned*)(lds + MISC_OFF);
    const int tid = threadIdx.x, lane = tid & 63, wave = __builtin_amdgcn_readfirstlane(tid >> 6);
    const Ptrs& P = args.p;
    unsigned char* ws = P.ws;
    gu32* ctl = (gu32*)(ws + WS_CTL);
    for (int u = tid; u < (LDS_BYTES - LDSCTL_OFF) / 4; u += NWAVES * 64) ((LAS unsigned*)(lds + LDSCTL_OFF))[u] = 0u;
    __syncthreads();
    const int lo = args.ph_lo, hi = args.ph_hi;
    XcdBarrier bar; bar.bar = (unsigned*)(ctl + CW_BAR); bar.x = 0; bar.st = nullptr;
    if (hi - lo > 1 && !FLAT_BAR) bar = xcd_barrier_post((unsigned*)(ctl + CW_BAR), MISC + 8);
#define IN(k) (lo <= (k) && (k) < hi)
#define SEAM(k) do { if (IN(k) && IN((k) + 1)) GRID_BARRIER(); } while (0)
    bf16* hb = (bf16*)(ws + WS_HB); bf16* ob = (bf16*)(ws + WS_OB); bf16* act = (bf16*)(ws + WS_ACT); float* part = (float*)(ws + WS_PART);
    const int G = gridDim.x, bx = blockIdx.x;

#ifndef DUP_MASK
#define DUP_MASK 0u
#endif
#ifndef EXTRA_BARS
#define EXTRA_BARS 0
#endif
#define DUP(k) ((DUP_MASK >> (k)) & 1u)
    if (IN(0)) { if (DUP(0)) { p0_prologue(P, lds, wave, lane); GRID_BARRIER(); } p0_prologue(P, lds, wave, lane); } SEAM(0);
    for (int eb_ = 0; eb_ < EXTRA_BARS; ++eb_) GRID_BARRIER();
#define WFIN(i) ((const bf16*)(ws + WS_WFIN) + (size_t)(i) * 2 * FF * DM)
#define WFOUT(i) ((const bf16*)(ws + WS_WFOUT) + (size_t)(i) * DM * FF)
#ifndef PROBE_EPI
#define PROBE_EPI 0
#endif
#define PH_FFN_IN(k, wi, CA, CB, CC) do { if (IN(k)) { if (DUP(k)) { pg8::Gemm g{hb, WFIN(wi), M, 2 * FF, DM}; pg8::StaticOrder S; S.init(M, 2 * FF, G, bx); \
        pg8::EpiSwigluT<PROBE_EPI> E{act, FF, part}; pg8::gemm_phase<pg8::EpiSwigluT<PROBE_EPI>, pg8::StaticOrder, true, true>(lds + RING_OFF, g, S, E); GRID_BARRIER(); } \
        convert_in_slack<CA, CB, CC>(P, lds, wave, lane, (M / 256) * (2 * FF / 256)); \
        pg8::Gemm g{hb, WFIN(wi), M, 2 * FF, DM}; pg8::StaticOrder S; S.init(M, 2 * FF, G, bx); \
        pg8::EpiSwiglu E{act, FF, part}; pg8::gemm_phase<pg8::EpiSwiglu, pg8::StaticOrder, true, true>(lds + RING_OFF, g, S, E); } SEAM(k); } while (0)
#define PH_FFN_OUT_(k, wi, obp, partp) do { pg8::Gemm g{act, WFOUT(wi), M, DM, FF}; pg8::StaticOrder S; S.init(M, DM, G, bx); \
        pg8::EpiResid E{hb, obp, partp, 0.5f}; pg8::gemm_phase<pg8::EpiResid, pg8::StaticOrder, true, true>(lds + RING_OFF, g, S, E); } while (0)
#define PH_FFN_OUT(k, wi) do { if (IN(k)) { if (DUP(k)) { PH_FFN_OUT_(k, wi, ob, (float*)(ws + WS_END)); GRID_BARRIER(); } PH_FFN_OUT_(k, wi, hb, part); } SEAM(k); } while (0)
#define PH_MIX_IN(k, woff, NN, CA, CB, CC) do { if (IN(k)) for (int rep_ = DUP(k) ? 2 : 1; rep_ > 0; --rep_) { if (rep_ == 1 && DUP(k)) GRID_BARRIER(); if (rep_ == 1) convert_in_slack<CA, CB, CC>(P, lds, wave, lane, (M / 256) * ((NN) / 256)); pg8::Gemm g{hb, (const bf16*)(ws + (woff)), M, NN, DM}; pg8::StaticOrder S; S.init(M, NN, G, bx); \
        pg8::EpiRowScale E{act, NN, part}; pg8::gemm_phase<pg8::EpiRowScale, pg8::StaticOrder, true, true>(lds + RING_OFF, g, S, E); } SEAM(k); } while (0)
#define PH_MIX_OUT_(k, woff, obp, partp) do { pg8::Gemm g{ob, (const bf16*)(ws + (woff)), M, DM, DM}; pg8::StaticOrder S; S.init(M, DM, G, bx); \
        pg8::EpiResid E{hb, obp, partp, 1.0f}; pg8::gemm_phase<pg8::EpiResid, pg8::StaticOrder, true, true>(lds + RING_OFF, g, S, E); } while (0)
#define PH_MIX_OUT(k, woff) do { if (IN(k)) { if (DUP(k)) { PH_MIX_OUT_(k, woff, act, (float*)(ws + WS_END)); GRID_BARRIER(); } PH_MIX_OUT_(k, woff, hb, part); } SEAM(k); } while (0)
    PH_FFN_IN(1, 0, 4, 8, 9); PH_FFN_OUT(2, 0);
    PH_MIX_IN(3, WS_WAIN, AIN, 1, 5, -1);
    if (IN(4)) { if (DUP(4)) { attn_phase(P, lds, wave, lane); GRID_BARRIER(); } attn_phase(P, lds, wave, lane); } SEAM(4);
    PH_MIX_OUT(5, WS_WAOUT);
    PH_FFN_IN(6, 1, 2, -1, -1); PH_FFN_OUT(7, 1);
    PH_FFN_IN(8, 2, 6, 10, 11); PH_FFN_OUT(9, 2);
    PH_MIX_IN(10, WS_WRIN, RIN, 3, 7, -1);
    if (IN(11)) { if (DUP(11)) { rec_pass_a(P, lds, wave, lane); GRID_BARRIER(); } rec_pass_a(P, lds, wave, lane); } SEAM(11);
    if (IN(12)) { if (DUP(12)) { rec_pass_b(P); GRID_BARRIER(); } rec_pass_b(P); } SEAM(12);
    if (IN(13)) { if (DUP(13)) { rec_pass_c(P, lds, wave, lane); GRID_BARRIER(); } rec_pass_c(P, lds, wave, lane); } SEAM(13);
    PH_MIX_OUT(14, WS_WROUT);
    PH_FFN_IN(15, 3, -1, -1, -1); PH_FFN_OUT(16, 3);
    if (IN(N_PHASES - 1)) final_norm(P, wave, lane);
#undef IN
#undef SEAM
}

#ifndef MK_PER_PHASE
#define MK_PER_PHASE 0
#endif
extern "C" void kernel_launch(void* const* d_in, const int* in_sizes, int n_in, void* d_out, int out_size, void* d_ws, size_t ws_size, hipStream_t stream) {
    static int grid = 0;
    if (grid == 0) {
        if (n_in != 13 || in_sizes[0] != M * DM || out_size != M * DM || ws_size < WS_END + MiB) { fprintf(stderr, "kernel_launch: unexpected shapes (n_in %d, in0 %d, out %d, ws %zu); nothing launched\n", n_in, n_in > 0 ? in_sizes[0] : -1, out_size, ws_size); grid = -1; return; }
        int dev = 0, cus = 0, per_cu = 0;
        if (hipGetDevice(&dev) != hipSuccess || hipDeviceGetAttribute(&cus, hipDeviceAttributeMultiprocessorCount, dev) != hipSuccess) { grid = -1; return; }
        if (hipFuncSetAttribute((const void*)trunk_fwd, hipFuncAttributeMaxDynamicSharedMemorySize, LDS_BYTES) != hipSuccess) { fprintf(stderr, "kernel_launch: hipFuncSetAttribute failed\n"); grid = -1; return; }
        if (hipOccupancyMaxActiveBlocksPerMultiprocessor(&per_cu, (const void*)trunk_fwd, NWAVES * 64, LDS_BYTES) != hipSuccess || per_cu < 1) { fprintf(stderr, "kernel_launch: occupancy query says %d blocks per CU\n", per_cu); per_cu = 1; }
        (void)hipGetLastError();
        grid = cus;
    }
    if (grid < 0) return;
    (void)hipMemsetAsync((char*)d_ws + WS_CTL, 0, CTL_ZERO_BYTES, stream);
    Args a{};
    const float** pp = (const float**)&a.p;
    for (int i = 0; i < 13; ++i) pp[i] = (const float*)d_in[i];
    a.p.out = (float*)d_out; a.p.ws = (unsigned char*)d_ws;
#if MK_PER_PHASE
    for (int k = 0; k < N_PHASES; ++k) { a.ph_lo = k; a.ph_hi = k + 1; hipLaunchKernelGGL(trunk_fwd, dim3(grid), dim3(NWAVES * 64), LDS_BYTES, stream, a); }
#else
    a.ph_lo = 0; a.ph_hi = N_PHASES; hipLaunchKernelGGL(trunk_fwd, dim3(grid), dim3(NWAVES * 64), LDS_BYTES, stream, a);
#endif
}
```
